# Optimizing an MI355X kernel written in HIP

```python
import jax, jax.numpy as jnp
from jax import lax
import numpy as np

D_MODEL = 2048
BATCH = 2
SEQ = 8192
DEPTH = 2

N_A_LAYERS = DEPTH // 2
N_B_LAYERS = DEPTH - N_A_LAYERS
PLE_DIM = 256
EPS = 1e-6

M_HEADS = 4
M_QK_DIM = D_MODEL // 2 // M_HEADS
M_V_DIM = D_MODEL // M_HEADS
M_CHUNK = 64
GATE_CAP = 15.0
M_IN_COLS = 2 * M_HEADS * M_QK_DIM + 2 * M_HEADS * M_V_DIM + 2 * M_HEADS

A_HEAD_DIM = 64
A_Q_HEADS = D_MODEL // A_HEAD_DIM
A_KV_HEADS = A_Q_HEADS // 8
A_GROUP = A_Q_HEADS // A_KV_HEADS
WINDOW = 128
A_BLOCK = WINDOW

P_HEADS = 8
P_NKEYS = 128
P_EXPERTS = P_NKEYS * P_NKEYS
P_QDIM = 256
P_HALF = P_QDIM // 2
P_TOPK = 16
P_TOKEN_CHUNK = 128

kernel_name = "yoco_mlstm_swa_sink_peer_ple"


def rms_norm(x, w):
    xf = x.astype(jnp.float32)
    y = xf * lax.rsqrt(jnp.mean(xf * xf, axis=-1, keepdims=True) + EPS)
    return (y * w.astype(jnp.float32)).astype(x.dtype)


def soft_cap(t):
    return GATE_CAP * jnp.tanh(t / GATE_CAP)


def mlstm_mixer(xn, w_in, gate_bias, head_norm, w_out):
    B, S, _ = xn.shape
    H, DK, DV, L = M_HEADS, M_QK_DIM, M_V_DIM, M_CHUNK
    NC = S // L
    proj = (xn @ w_in).astype(jnp.float32)
    o0 = H * DK
    o1 = 2 * H * DK
    o2 = o1 + H * DV
    o3 = o2 + H * DV
    o4 = o3 + H
    q = proj[..., :o0]
    k = proj[..., o0:o1]
    v = proj[..., o1:o2]
    og = proj[..., o2:o3]
    gb = gate_bias.astype(jnp.float32)
    log_i = soft_cap(proj[..., o3:o4] + gb[0])
    log_f = jax.nn.log_sigmoid(soft_cap(proj[..., o4:] + gb[1]))

    def to_chunks(t, d):
        return t.reshape(B, NC, L, H, d).transpose(1, 0, 3, 2, 4)

    def gate_chunks(t):
        return t.reshape(B, NC, L, H).transpose(1, 0, 3, 2)

    qc = to_chunks(q, DK) * (DK ** -0.5)
    kc = to_chunks(k, DK)
    vc = to_chunks(v, DV)
    gi = gate_chunks(log_i)
    gf = gate_chunks(log_f)
    causal = jnp.tril(jnp.ones((L, L), dtype=bool))

    def step(carry, inp):
        C, n, m = carry
        qb, kb, vb, li, lf = inp
        b = jnp.cumsum(lf, axis=-1)
        dmat = b[..., :, None] - b[..., None, :] + li[..., None, :]
        dmat = jnp.where(causal, dmat, -jnp.inf)
        inter = b + m[..., None]
        m_t = jnp.maximum(inter, jnp.max(dmat, axis=-1))
        w_intra = jnp.exp(dmat - m_t[..., None])
        w_inter = jnp.exp(inter - m_t)
        s = jnp.einsum('bhld,bhsd->bhls', qb, kb) * w_intra
        num = (w_inter[..., None] * jnp.einsum('bhld,bhde->bhle', qb, C)
               + jnp.einsum('bhls,bhse->bhle', s, vb))
        den = w_inter * jnp.einsum('bhld,bhd->bhl', qb, n) + jnp.sum(s, axis=-1)
        h = num / jnp.maximum(jnp.abs(den), jnp.exp(-m_t))[..., None]
        m_new = m_t[..., -1]
        w_state = jnp.exp(b[..., -1:] - b + li - m_new[..., None])
        decay = jnp.exp(b[..., -1] + m - m_new)
        C_new = decay[..., None, None] * C + jnp.einsum('bhs,bhsd,bhse->bhde', w_state, kb, vb)
        n_new = decay[..., None] * n + jnp.einsum('bhs,bhsd->bhd', w_state, kb)
        return (C_new, n_new, m_new), h

    init = (jnp.zeros((B, H, DK, DV), jnp.float32),
            jnp.zeros((B, H, DK), jnp.float32),
            jnp.zeros((B, H), jnp.float32))
    _, hs = lax.scan(step, init, (qc, kc, vc, gi, gf))
    h = hs.transpose(1, 0, 3, 2, 4).reshape(B, S, H, DV)
    h = h * lax.rsqrt(jnp.mean(h * h, axis=-1, keepdims=True) + EPS)
    h = h * head_norm.astype(jnp.float32).reshape(H, DV)
    h = h.reshape(B, S, H * DV) * jax.nn.sigmoid(og)
    return h.astype(xn.dtype) @ w_out


def swa_sink_mixer(xn, k, v, w_q, sinks, w_out):
    B, S, _ = xn.shape
    NBLK = S // A_BLOCK
    q = (xn @ w_q).reshape(B, NBLK, A_BLOCK, A_KV_HEADS, A_GROUP, A_HEAD_DIM)
    pad = ((0, 0), (A_BLOCK, 0), (0, 0), (0, 0))
    kb = jnp.pad(k, pad).reshape(B, NBLK + 1, A_BLOCK, A_KV_HEADS, A_HEAD_DIM)
    vb = jnp.pad(v, pad).reshape(B, NBLK + 1, A_BLOCK, A_KV_HEADS, A_HEAD_DIM)
    kw = jnp.concatenate([kb[:, :-1], kb[:, 1:]], axis=2)
    vw = jnp.concatenate([vb[:, :-1], vb[:, 1:]], axis=2)
    s = jnp.einsum('bnqkgd,bnskd->bnkgqs', q, kw).astype(jnp.float32) * (A_HEAD_DIM ** -0.5)
    qpos = jnp.arange(A_BLOCK)[:, None] + A_BLOCK
    kpos = jnp.arange(2 * A_BLOCK)[None, :]
    dist = qpos - kpos
    band = (dist >= 0) & (dist < WINDOW)
    valid = (jnp.arange(NBLK)[:, None, None] * A_BLOCK + kpos[None] - A_BLOCK) >= 0
    mask = band[None] & valid
    s = jnp.where(mask[None, :, None, None], s, -jnp.inf)
    sink = sinks.astype(jnp.float32).reshape(A_KV_HEADS, A_GROUP)[None, None, :, :, None, None]
    mx = jnp.maximum(jnp.max(s, axis=-1, keepdims=True), sink)
    pr = jnp.exp(s - mx)
    pr = pr / (jnp.sum(pr, axis=-1, keepdims=True) + jnp.exp(sink - mx))
    o = jnp.einsum('bnkgqs,bnskd->bnqkgd', pr.astype(vw.dtype), vw)
    return o.reshape(B, S, A_Q_HEADS * A_HEAD_DIM) @ w_out


def peer_mixer(xn, w_q, k1, k2, u, v):
    B, S, D = xn.shape
    xt = xn.reshape((B * S) // P_TOKEN_CHUNK, P_TOKEN_CHUNK, D)

    def chunk(xc):
        q = (xc @ w_q).reshape(-1, P_HEADS, 2, P_HALF)
        s1 = jnp.einsum('chd,hnd->chn', q[:, :, 0], k1).astype(jnp.float32)
        s2 = jnp.einsum('chd,hnd->chn', q[:, :, 1], k2).astype(jnp.float32)
        v1, i1 = lax.top_k(s1, P_TOPK)
        v2, i2 = lax.top_k(s2, P_TOPK)
        cand = (v1[..., :, None] + v2[..., None, :]).reshape(-1, P_HEADS, P_TOPK * P_TOPK)
        cidx = (i1[..., :, None] * P_NKEYS + i2[..., None, :]).reshape(-1, P_HEADS, P_TOPK * P_TOPK)
        top_s, pos = lax.top_k(cand, P_TOPK)
        eidx = jnp.take_along_axis(cidx, pos, axis=-1)
        g = jax.nn.softmax(top_s, axis=-1)
        ue = u[eidx]
        act = jax.nn.gelu(jnp.einsum('cd,chkd->chk', xc, ue).astype(jnp.float32), approximate=False)
        coef = (g * act).astype(xc.dtype)
        ve = v[eidx]
        return jnp.einsum('chk,chkd->cd', coef, ve)

    y = lax.map(chunk, xt)
    return y.reshape(B, S, D)


def setup_inputs(seed: int = 0) -> dict:
    key = jax.random.key(seed)
    ks = jax.random.split(key, 32)
    f32 = jnp.float32
    nrm = lambda k, shape, scale: jax.random.normal(k, shape, f32) * scale
    gain = lambda k, shape: 1.0 + 0.02 * jax.random.normal(k, shape, f32)
    gate_noise = nrm(ks[4], (N_A_LAYERS, 2, M_HEADS), 0.3)
    gate_bias = gate_noise + jnp.array([-1.0, 3.0], f32)[None, :, None]
    return {
        "x": nrm(ks[0], (BATCH, SEQ, D_MODEL), 1.0),
        "p": nrm(ks[1], (DEPTH, BATCH, SEQ, PLE_DIM), 1.0),
        "a_norm": gain(ks[2], (N_A_LAYERS, D_MODEL)),
        "a_w_in": nrm(ks[3], (N_A_LAYERS, D_MODEL, M_IN_COLS), D_MODEL ** -0.5),
        "a_gate_bias": gate_bias,
        "a_head_norm": gain(ks[5], (N_A_LAYERS, M_HEADS * M_V_DIM)),
        "a_w_out": nrm(ks[6], (N_A_LAYERS, M_HEADS * M_V_DIM, D_MODEL), (M_HEADS * M_V_DIM) ** -0.5),
        "kv_norm": gain(ks[7], (D_MODEL,)),
        "w_kv": nrm(ks[8], (D_MODEL, 2 * A_KV_HEADS * A_HEAD_DIM), D_MODEL ** -0.5),
        "b_norm": gain(ks[9], (N_B_LAYERS, D_MODEL)),
        "b_w_q": nrm(ks[10], (N_B_LAYERS, D_MODEL, A_Q_HEADS * A_HEAD_DIM), D_MODEL ** -0.5),
        "b_sinks": nrm(ks[11], (N_B_LAYERS, A_Q_HEADS), 0.5),
        "b_w_out": nrm(ks[12], (N_B_LAYERS, A_Q_HEADS * A_HEAD_DIM, D_MODEL), (A_Q_HEADS * A_HEAD_DIM) ** -0.5),
        "c_norm": gain(ks[13], (DEPTH, D_MODEL)),
        "peer_w_q": nrm(ks[14], (DEPTH, D_MODEL, P_HEADS * P_QDIM), D_MODEL ** -0.5),
        "peer_k1": nrm(ks[15], (DEPTH, P_HEADS, P_NKEYS, P_HALF), P_HALF ** -0.5),
        "peer_k2": nrm(ks[16], (DEPTH, P_HEADS, P_NKEYS, P_HALF), P_HALF ** -0.5),
        "peer_u": nrm(ks[17], (DEPTH, P_EXPERTS, D_MODEL), D_MODEL ** -0.5),
        "peer_v": nrm(ks[18], (DEPTH, P_EXPERTS, D_MODEL), 0.5 * P_HEADS ** -0.5),
        "ple_norm": gain(ks[19], (DEPTH, D_MODEL)),
        "ple_w_gate": nrm(ks[20], (DEPTH, D_MODEL, D_MODEL), D_MODEL ** -0.5),
        "ple_w_proj": nrm(ks[21], (DEPTH, PLE_DIM, D_MODEL), PLE_DIM ** -0.5),
        "final_norm": gain(ks[22], (D_MODEL,)),
    }


def reference(x, p, a_norm, a_w_in, a_gate_bias, a_head_norm, a_w_out, kv_norm, w_kv,
              b_norm, b_w_q, b_sinks, b_w_out, c_norm, peer_w_q, peer_k1, peer_k2,
              peer_u, peer_v, ple_norm, ple_w_gate, ple_w_proj, final_norm):
    B, S, _ = x.shape
    h = x
    k_sh = None
    v_sh = None
    for i in range(DEPTH):
        if i < N_A_LAYERS:
            h = h + mlstm_mixer(rms_norm(h, a_norm[i]), a_w_in[i], a_gate_bias[i],
                                a_head_norm[i], a_w_out[i])
        else:
            if i == N_A_LAYERS:
                kv = rms_norm(h, kv_norm) @ w_kv
                kv = kv.reshape(B, S, 2, A_KV_HEADS, A_HEAD_DIM)
                k_sh = kv[:, :, 0]
                v_sh = kv[:, :, 1]
            j = i - N_A_LAYERS
            h = h + swa_sink_mixer(rms_norm(h, b_norm[j]), k_sh, v_sh, b_w_q[j], b_sinks[j], b_w_out[j])
        h = h + peer_mixer(rms_norm(h, c_norm[i]), peer_w_q[i], peer_k1[i], peer_k2[i],
                           peer_u[i], peer_v[i])
        gate = jax.nn.sigmoid((rms_norm(h, ple_norm[i]) @ ple_w_gate[i]).astype(jnp.float32))
        h = h + (gate * (p[i] @ ple_w_proj[i]).astype(jnp.float32)).astype(h.dtype)
    return rms_norm(h, final_norm)
```

```cpp
#include <hip/hip_runtime.h>
#include <hip/hip_cooperative_groups.h>
#include <cstdio>
#include <cstdint>
#include <cmath>
namespace cg = cooperative_groups;
namespace pg8 {
#define PG8_LAS __attribute__((address_space(3)))
typedef unsigned short bf16_t;
typedef short bf16x8 __attribute__((ext_vector_type(8)));
typedef float f32x4 __attribute__((ext_vector_type(4)));
typedef unsigned u32x4 __attribute__((ext_vector_type(4)));
constexpr int BM = 256, BK = 64, HALF = 128, HTB = HALF * BK * 2  , STAGE_BYTES = 8 * HTB, NXCD = 8, WGM = 8;

__host__ __device__ __forceinline__ int lds_byte(int r, int c) { const int st = (r >> 4) * 2 + (c >> 5), rr = r & 15, cc = c & 31, ob = rr * 64 + cc * 2; return st * 1024 + (ob ^ (((ob >> 9) & 1) << 5)); }
__host__ __device__ __forceinline__ void stage_rc(int b, int& R, int& C) { const int st = b / 1024, sb = b % 1024, swz = sb ^ (((sb >> 9) & 1) << 5); R = (st >> 1) * 16 + swz / 64; C = (st & 1) * 32 + (swz % 64) / 2; }
__host__ __device__ __forceinline__ int perm32(int rho) { const int n = rho >> 4, i = rho & 15; return 8 * (i >> 2) + 4 * n + (i & 3); }

struct Unit { int pm, pn; };
struct Gemm { const bf16_t* A; const bf16_t* Bt; int M, N, K; };

struct StaticOrder {
    int nM, nN, nwg, G, c;
    __host__ __device__ void init(int M, int N, int G_, int c_) { nM = M / BM; nN = N / BM; nwg = nM * nN; G = G_; c = c_; }
    __host__ __device__ bool next(int i, Unit& u) const {
        const long L = (long)i * G + c; if (L >= nwg) return false;
        int wgid = (int)L; { const int q = nwg / NXCD, r = nwg % NXCD, xcd = wgid % NXCD, off = wgid / NXCD; wgid = (xcd < r ? xcd * (q + 1) : r * (q + 1) + (xcd - r) * q) + off; }
        const int nig = WGM * nN, gid = wgid / nig, fm = gid * WGM, gsz = (nM - fm) < WGM ? (nM - fm) : WGM;
        u.pm = fm + ((wgid % nig) % gsz); u.pn = (wgid % nig) / gsz; return true;
    }
    __device__ __forceinline__ void a_ready(const Unit&) const {}
    __device__ __forceinline__ void done(const Unit&) const {}
};
__device__ __forceinline__ unsigned cvt_pk_bf16(float lo, float hi) { unsigned r; asm volatile("v_cvt_pk_bf16_f32 %0, %1, %2" : "=v"(r) : "v"(lo), "v"(hi)); return r; }
template <class Epi, class Sched, bool ALIGN_EPI = false, bool SP2 = false>
__device__ __forceinline__ void gemm_phase(PG8_LAS unsigned char* lds, const Gemm g, const Sched& S, const Epi& E) {
    const int tid = threadIdx.x, wid = __builtin_amdgcn_readfirstlane(tid >> 6), lane = tid & 63, wr = wid >> 2, wc = wid & 3, fr = lane & 15, fq = lane >> 4;
    const int K = g.K, nt = K / BK;
    unsigned voffA[2], voffB[2];
#pragma unroll
    for (int i = 0; i < 2; ++i) { int R, C; stage_rc(tid * 16 + i * 8192, R, C); const int Rb = Epi::PERM ? ((R & ~31) + perm32(R & 31)) : R;
        voffA[i] = (unsigned)(R * K + C) * 2u; voffB[i] = (unsigned)(Rb * K + C) * 2u; }
    const size_t kstep = (size_t)(BK * 2);
    const size_t hstep = (size_t)HALF * K * 2;
    const size_t tstep = 2 * hstep;
    const unsigned ldsw = (unsigned)wid * 1024u;
    const int aoff = lds_byte(wr * 64 + fr, fq * 8), boff = lds_byte(wc * 32 + fr, fq * 8);
#define PG8_SA(b, h) (((b) * 2 + (h)) * HTB)
#define PG8_SB(b, h) ((4 + (b) * 2 + (h)) * HTB)
#define PG8_STAGE(bufoff, gbase, voff) do { _Pragma("unroll") for (int _i = 0; _i < 2; ++_i) \
        __builtin_amdgcn_global_load_lds((const unsigned*)((const char*)(gbase) + (voff)[_i]), (PG8_LAS unsigned*)(lds + (bufoff) + ldsw + _i * 8192), 16, 0, 0); } while (0)
#define PG8_LDA(dst, b, h) do { _Pragma("unroll") for (int m = 0; m < 4; ++m) _Pragma("unroll") for (int k = 0; k < 2; ++k) dst[m][k] = *(const PG8_LAS bf16x8*)(lds + PG8_SA(b, h) + aoff + m * 2048 + k * 1024); } while (0)
#define PG8_LDB(dst, b, h) do { _Pragma("unroll") for (int n = 0; n < 2; ++n) _Pragma("unroll") for (int k = 0; k < 2; ++k) dst[n][k] = *(const PG8_LAS bf16x8*)(lds + PG8_SB(b, h) + boff + n * 2048 + k * 1024); } while (0)
#define PG8_MMA(ai, bj, At, Bt) do { __builtin_amdgcn_s_setprio(1); _Pragma("unroll") for (int m = 0; m < 4; ++m) _Pragma("unroll") for (int n = 0; n < 2; ++n) _Pragma("unroll") for (int k = 0; k < 2; ++k) \
        acc[ai][bj][m][n] = __builtin_amdgcn_mfma_f32_16x16x32_bf16(Bt[n][k], At[m][k], acc[ai][bj][m][n], 0, 0, 0); __builtin_amdgcn_s_setprio(0); } while (0)
#define PG8_WAIT_V(n) asm volatile("s_waitcnt vmcnt(" #n ")" ::: "memory")
#define PG8_WAIT_L(n) asm volatile("s_waitcnt lgkmcnt(" #n ")" ::: "memory")
#define PG8_BAR __builtin_amdgcn_s_barrier()
#define PG8_SCHED __builtin_amdgcn_sched_barrier(0)
    Unit cur, nxt; int ui = 0;
    if (!S.next(0, cur)) return;
    f32x4 acc[2][2][4][2];
#pragma unroll
    for (int a = 0; a < 2; ++a)
#pragma unroll
        for (int b = 0; b < 2; ++b)
#pragma unroll
            for (int m = 0; m < 4; ++m)
#pragma unroll
                for (int n = 0; n < 2; ++n) acc[a][b][m][n] = (f32x4){0.f, 0.f, 0.f, 0.f};
    bf16x8 At[4][2], B0[2][2], B1[2][2];
    const char* cA = (const char*)g.A + (size_t)cur.pm * tstep; const char* cB = (const char*)g.Bt + (size_t)cur.pn * tstep;
    S.a_ready(cur);
    if constexpr (SP2) {
        PG8_STAGE(PG8_SB(0, 0), cB, voffB); PG8_STAGE(PG8_SB(0, 1), cB + hstep, voffB); PG8_STAGE(PG8_SA(0, 0), cA, voffA); PG8_STAGE(PG8_SA(0, 1), cA + hstep, voffA);
        if (wr == 1) PG8_BAR;
        PG8_WAIT_V(2); PG8_BAR;
        PG8_STAGE(PG8_SB(1, 0), cB + kstep, voffB); PG8_STAGE(PG8_SA(1, 0), cA + kstep, voffA); PG8_STAGE(PG8_SB(1, 1), cB + hstep + kstep, voffB);
        PG8_WAIT_V(6); PG8_BAR;
    } else {
        PG8_STAGE(PG8_SB(0, 0), cB, voffB); PG8_STAGE(PG8_SA(0, 0), cA, voffA); PG8_STAGE(PG8_SB(0, 1), cB + hstep, voffB); PG8_STAGE(PG8_SA(0, 1), cA + hstep, voffA);
        if (wr == 1) PG8_BAR;
        PG8_WAIT_V(4); PG8_BAR;
        PG8_STAGE(PG8_SB(1, 0), cB + kstep, voffB); PG8_STAGE(PG8_SA(1, 0), cA + kstep, voffA); PG8_STAGE(PG8_SB(1, 1), cB + hstep + kstep, voffB);
        PG8_WAIT_V(6); PG8_BAR;
    }
    for (;;) {
        const bool has_next = S.next(ui + 1, nxt);
        const char* nA = has_next ? (const char*)g.A + (size_t)nxt.pm * tstep : cA; const char* nB = has_next ? (const char*)g.Bt + (size_t)nxt.pn * tstep : cB;
        for (int t = 0; t < nt; t += 2) {
            const bool last = (t == nt - 2);
            const char* a1 = cA + (size_t)(t + 1) * kstep;
            const char* a2 = last ? nA : cA + (size_t)(t + 2) * kstep; const char* b2 = last ? nB : cB + (size_t)(t + 2) * kstep;
            const char* a3 = a2 + kstep; const char* b3 = b2 + kstep;
            if (last && has_next) S.a_ready(nxt);
            if constexpr (SP2) {
            PG8_LDB(B0, 0, 0); PG8_LDB(B1, 0, 1); PG8_SCHED; PG8_LDA(At, 0, 0); PG8_STAGE(PG8_SA(1, 1), a1 + hstep, voffA);
            PG8_WAIT_V(8); PG8_WAIT_L(0); PG8_BAR; PG8_MMA(0, 0, At, B0); PG8_MMA(0, 1, At, B1); PG8_BAR; PG8_SCHED;
            PG8_LDA(At, 0, 1); PG8_STAGE(PG8_SB(0, 0), b2, voffB); PG8_STAGE(PG8_SB(0, 1), b2 + hstep, voffB); PG8_STAGE(PG8_SA(0, 0), a2, voffA);
            PG8_WAIT_V(8); PG8_WAIT_L(0); PG8_BAR; PG8_MMA(1, 0, At, B0); PG8_MMA(1, 1, At, B1); PG8_BAR; PG8_SCHED;
            PG8_LDB(B0, 1, 0); PG8_LDB(B1, 1, 1); PG8_SCHED; PG8_LDA(At, 1, 0); PG8_STAGE(PG8_SA(0, 1), a2 + hstep, voffA);
            PG8_WAIT_V(8); PG8_WAIT_L(0); PG8_BAR; PG8_MMA(0, 0, At, B0); PG8_MMA(0, 1, At, B1); PG8_BAR; PG8_SCHED;
            PG8_LDA(At, 1, 1); PG8_STAGE(PG8_SB(1, 0), b3, voffB); PG8_STAGE(PG8_SB(1, 1), b3 + hstep, voffB); PG8_STAGE(PG8_SA(1, 0), a3, voffA);
            PG8_WAIT_V(8); PG8_WAIT_L(0); PG8_BAR; PG8_MMA(1, 0, At, B0); PG8_MMA(1, 1, At, B1); PG8_BAR; PG8_SCHED;
            } else {
            PG8_LDB(B0, 0, 0); PG8_SCHED; PG8_LDA(At, 0, 0); PG8_STAGE(PG8_SA(1, 1), a1 + hstep, voffA);
            PG8_WAIT_L(8); PG8_BAR; PG8_WAIT_L(0); PG8_MMA(0, 0, At, B0); PG8_BAR; PG8_SCHED;
            PG8_LDB(B1, 0, 1); PG8_STAGE(PG8_SB(0, 0), b2, voffB);
            PG8_BAR; PG8_WAIT_L(0); PG8_MMA(0, 1, At, B1); PG8_BAR;
            PG8_LDA(At, 0, 1); PG8_STAGE(PG8_SA(0, 0), a2, voffA);
            PG8_BAR; PG8_WAIT_L(0); PG8_MMA(1, 0, At, B0); PG8_BAR; PG8_SCHED;
            PG8_STAGE(PG8_SB(0, 1), b2 + hstep, voffB);
            PG8_WAIT_V(6); PG8_BAR; PG8_MMA(1, 1, At, B1); PG8_BAR;
            PG8_LDB(B0, 1, 0); PG8_SCHED; PG8_LDA(At, 1, 0); PG8_STAGE(PG8_SA(0, 1), a2 + hstep, voffA);
            PG8_WAIT_L(8); PG8_BAR; PG8_WAIT_L(0); PG8_MMA(0, 0, At, B0); PG8_BAR; PG8_SCHED;
            PG8_LDB(B1, 1, 1); PG8_STAGE(PG8_SB(1, 0), b3, voffB);
            PG8_BAR; PG8_WAIT_L(0); PG8_MMA(0, 1, At, B1); PG8_BAR;
            PG8_LDA(At, 1, 1); PG8_STAGE(PG8_SA(1, 0), a3, voffA);
            PG8_BAR; PG8_WAIT_L(0); PG8_MMA(1, 0, At, B0); PG8_BAR; PG8_SCHED;
            PG8_STAGE(PG8_SB(1, 1), b3 + hstep, voffB);
            PG8_WAIT_V(6); PG8_BAR; PG8_MMA(1, 1, At, B1); PG8_BAR;
            }
        }
        if constexpr (ALIGN_EPI) { if (wr == 0) PG8_BAR; }
        if constexpr (!Epi::AFTER_DRAIN) { E(acc, cur, wr, wc, fr, fq); S.done(cur); }
        if (!has_next) break;
#pragma unroll
        for (int a = 0; a < 2; ++a)
#pragma unroll
            for (int b = 0; b < 2; ++b)
#pragma unroll
                for (int m = 0; m < 4; ++m)
#pragma unroll
                    for (int n = 0; n < 2; ++n) acc[a][b][m][n] = (f32x4){0.f, 0.f, 0.f, 0.f};
        cur = nxt; cA = nA; cB = nB; ++ui;
        if constexpr (ALIGN_EPI) { if (wr == 1) PG8_BAR; }
    }
    PG8_WAIT_V(0);
    if constexpr (!ALIGN_EPI) { if (wr == 0) PG8_BAR; }
    PG8_BAR;
    if constexpr (Epi::AFTER_DRAIN) { E.fused(acc, cur, wr, wc, fr, fq, lds, wid, lane); S.done(cur); }
#undef PG8_SA
#undef PG8_SB
#undef PG8_STAGE
#undef PG8_LDA
#undef PG8_LDB
#undef PG8_MMA
#undef PG8_WAIT_V
#undef PG8_WAIT_L
#undef PG8_BAR
#undef PG8_SCHED
}
}
#define LAS __attribute__((address_space(3)))
typedef unsigned short bf16_t;
typedef short bf16x8 __attribute__((ext_vector_type(8)));
typedef float f32x4 __attribute__((ext_vector_type(4)));
typedef unsigned u32x4 __attribute__((ext_vector_type(4)));
typedef unsigned u32x2 __attribute__((ext_vector_type(2)));

constexpr int T = 16384, SEQ = 8192, D = 2048;
constexpr float EPS = 1e-6f;
constexpr int NSEG = 4, CSEG = 128 / NSEG;
constexpr size_t MiB = 1u << 20;
constexpr size_t WS_SS = 0;
constexpr size_t WS_GATES = 1 * MiB;
constexpr size_t WS_AA = 2 * MiB, WS_MM = WS_AA + 256 * 1024, WS_FF = WS_MM + 256 * 1024;
constexpr size_t WS_SEGN = 3 * MiB;
constexpr size_t WS_BAR = 3 * MiB + 64 * 1024;
constexpr size_t WS_USC = 3 * MiB + 256 * 1024, WS_VSC = WS_USC + 128 * 1024;
constexpr size_t WS_WIN = 4 * MiB;
constexpr size_t WS_WOUT = 28 * MiB;
constexpr size_t WS_WQKV = 36 * MiB;
constexpr size_t WS_WO = 46 * MiB;
constexpr size_t WS_WPQ = 54 * MiB;
constexpr size_t WS_WG = 70 * MiB;
constexpr size_t WS_WPR = 86 * MiB;
constexpr size_t WS_K1 = 88 * MiB, WS_K2 = 89 * MiB;
constexpr size_t WS_SEGST = 90 * MiB;
constexpr size_t WS_UB = 108 * MiB;
constexpr size_t WS_VB = 236 * MiB;
constexpr size_t WS_PB = 364 * MiB;
constexpr size_t WS_PP = 380 * MiB;
constexpr size_t WS_H = 444 * MiB;
constexpr size_t WS_HBA = 572 * MiB, WS_HBB = 636 * MiB;
constexpr size_t WS_R = 700 * MiB;
constexpr size_t WS_QK = WS_R;
constexpr size_t WS_OG = WS_R + 64 * MiB;
constexpr size_t WS_KVT = WS_R + 128 * MiB;
constexpr size_t WS_HM = WS_R + 224 * MiB;
constexpr size_t WS_EIDX = WS_R + 288 * MiB;
constexpr size_t WS_GW = WS_R + 296 * MiB;
constexpr size_t WS_QK2 = WS_R + 64 * MiB;
constexpr size_t WS_VT2 = WS_R + 136 * MiB;
constexpr size_t WS_O = WS_R + 144 * MiB;
constexpr size_t WS_SSP = WS_R + 304 * MiB;
constexpr size_t WS_SSQ = WS_R + 312 * MiB;
constexpr size_t WS_PA = WS_R + 64 * MiB;
constexpr size_t WS_CI = WS_R + 192 * MiB;
constexpr size_t WS_XQ = WS_R + 224 * MiB;
constexpr size_t WS_XS = WS_R + 256 * MiB;
constexpr size_t WS_END = WS_R + 316 * MiB;
constexpr int LDS_BYTES = 160 * 1024;

__device__ __forceinline__ unsigned pk2(float lo, float hi) { unsigned r; asm volatile("v_cvt_pk_bf16_f32 %0, %1, %2" : "=v"(r) : "v"(lo), "v"(hi)); return r; }
__device__ __forceinline__ float bflo(unsigned u) { return __uint_as_float(u << 16); }
__device__ __forceinline__ float bfhi(unsigned u) { return __uint_as_float(u & 0xffff0000u); }
__device__ __forceinline__ float wave_sum(float v) {
#pragma unroll
    for (int o = 1; o < 64; o <<= 1) v += __shfl_xor(v, o);
    return v;
}
__device__ __forceinline__ float rstd_of(float ss) { return 1.0f / sqrtf(ss * (1.0f / D) + EPS); }
__device__ __forceinline__ float sigmoidf_(float x) { return 1.0f / (1.0f + __expf(-x)); }
__device__ __forceinline__ f32x4 mfma16(bf16x8 a, bf16x8 b, f32x4 c) { return __builtin_amdgcn_mfma_f32_16x16x32_bf16(a, b, c, 0, 0, 0); }
__device__ __forceinline__ bf16x8 lfrag(const LAS unsigned char* base, int row, int stride, int kb) { return *(const LAS bf16x8*)(base + row * stride + kb); }
#define BLOCK_SYNC() __syncthreads()

struct Params { const float* in[23]; float* out; unsigned char* ws; int ph_lo, ph_hi; };
struct SSRef { const float* p; int n; };
__device__ __forceinline__ float ss_get(const SSRef s, int r) {
    if (s.n == 1) return s.p[r];
    const f32x4* q = (const f32x4*)(s.p + (size_t)r * s.n); f32x4 a = q[0];
    for (int i = 1; i < s.n / 4; ++i) a += q[i];
    return (a[0] + a[1]) + (a[2] + a[3]);
}
__device__ __forceinline__ float ss_get4(const SSRef s, int r, int fq) {
    if (s.n == 1) return s.p[r];
    const int per = s.n / 16; const f32x4* q = (const f32x4*)(s.p + (size_t)r * s.n) + fq * per; f32x4 a = q[0];
    for (int i = 1; i < per; ++i) a += q[i];
    float v = (a[0] + a[1]) + (a[2] + a[3]);
    v += __shfl_xor(v, 16); v += __shfl_xor(v, 32);
    return v;
}

struct EpiScale {
    static constexpr bool PERM = true, AFTER_DRAIN = false;
    bf16_t* O; int ldc; SSRef rss; SSRef css;
    __device__ __forceinline__ void operator()(const f32x4 (&acc)[2][2][4][2], const pg8::Unit& u, int wr, int wc, int fr, int fq) const {
        const int row0 = u.pm * 256 + wr * 64 + fr, col0 = u.pn * 256 + wc * 32 + 8 * fq;
        f32x4 cs[2][2];
#pragma unroll
        for (int bj = 0; bj < 2; ++bj)
#pragma unroll
            for (int n = 0; n < 2; ++n) {
                if (css.p) { const int c = col0 + bj * 128 + 4 * n; cs[bj][n] = (f32x4){rstd_of(ss_get(css, c)), rstd_of(ss_get(css, c + 1)), rstd_of(ss_get(css, c + 2)), rstd_of(ss_get(css, c + 3))}; }
                else cs[bj][n] = (f32x4){1.f, 1.f, 1.f, 1.f};
            }
#pragma unroll
        for (int ai = 0; ai < 2; ++ai)
#pragma unroll
            for (int m = 0; m < 4; ++m) {
                const int r = row0 + ai * 128 + m * 16;
                const float rs = rss.p ? rstd_of(ss_get4(rss, r, fq)) : 1.f;
                bf16_t* rowp = O + (size_t)r * ldc + col0;
#pragma unroll
                for (int bj = 0; bj < 2; ++bj) {
                    const f32x4 v0 = acc[ai][bj][m][0] * rs * cs[bj][0], v1 = acc[ai][bj][m][1] * rs * cs[bj][1];
                    u32x4 w; w.x = pk2(v0[0], v0[1]); w.y = pk2(v0[2], v0[3]); w.z = pk2(v1[0], v1[1]); w.w = pk2(v1[2], v1[3]);
                    *(u32x4*)(rowp + bj * 128) = w;
                }
            }
    }
};
template <bool GATE, bool HOLD32> struct EpiRes {
    static constexpr bool PERM = true, AFTER_DRAIN = false;
    const void* Hold; bf16_t* HB; float* SSout; const bf16_t* PP; SSRef rss;
    __device__ __forceinline__ void operator()(const f32x4 (&acc)[2][2][4][2], const pg8::Unit& u, int wr, int wc, int fr, int fq) const {
        const int row0 = u.pm * 256 + wr * 64 + fr, col0 = u.pn * 256 + wc * 32 + 8 * fq;
#pragma unroll
        for (int ai = 0; ai < 2; ++ai)
#pragma unroll
            for (int m = 0; m < 4; ++m) {
                const int r = row0 + ai * 128 + m * 16;
                float rs = 1.f; if (GATE) rs = rstd_of(ss_get4(rss, r, fq));
                float ssp = 0.f;
#pragma unroll
                for (int bj = 0; bj < 2; ++bj) {
                    const size_t off = (size_t)r * D + col0 + bj * 128;
                    f32x4 a0 = acc[ai][bj][m][0], a1 = acc[ai][bj][m][1];
                    if (GATE) {
                        const u32x4 pp = *(const u32x4*)(PP + off);
                        a0 = (f32x4){sigmoidf_(a0[0] * rs) * bflo(pp.x), sigmoidf_(a0[1] * rs) * bfhi(pp.x), sigmoidf_(a0[2] * rs) * bflo(pp.y), sigmoidf_(a0[3] * rs) * bfhi(pp.y)};
                        a1 = (f32x4){sigmoidf_(a1[0] * rs) * bflo(pp.z), sigmoidf_(a1[1] * rs) * bfhi(pp.z), sigmoidf_(a1[2] * rs) * bflo(pp.w), sigmoidf_(a1[3] * rs) * bfhi(pp.w)};
                    }
                    f32x4 h0, h1;
                    if (HOLD32) { h0 = *(const f32x4*)((const float*)Hold + off); h1 = *(const f32x4*)((const float*)Hold + off + 4); }
                    else { const u32x4 hb = *(const u32x4*)((const bf16_t*)Hold + off); h0 = (f32x4){bflo(hb.x), bfhi(hb.x), bflo(hb.y), bfhi(hb.y)}; h1 = (f32x4){bflo(hb.z), bfhi(hb.z), bflo(hb.w), bfhi(hb.w)}; }
                    const f32x4 v0 = h0 + a0, v1 = h1 + a1;
                    { u32x4 w; w.x = pk2(v0[0], v0[1]); w.y = pk2(v0[2], v0[3]); w.z = pk2(v1[0], v1[1]); w.w = pk2(v1[2], v1[3]); *(u32x4*)(HB + off) = w; }
                    ssp += (v0[0] * v0[0] + v0[1] * v0[1]) + (v0[2] * v0[2] + v0[3] * v0[3]) + (v1[0] * v1[0] + v1[1] * v1[1]) + (v1[2] * v1[2] + v1[3] * v1[3]);
                }
                ssp += __shfl_xor(ssp, 16); ssp += __shfl_xor(ssp, 32);
                if (fq == 0) SSout[(size_t)r * 32 + u.pn * 4 + wc] = ssp;
                asm volatile("" ::: "memory");
            }
    }
};
template <class Epi> __device__ __forceinline__ void run_gemm(LAS unsigned char* lds, const bf16_t* A, const bf16_t* Bt, int M, int N, int K, const Epi& E, const int rot = 0) {
    const int G = (int)gridDim.x; pg8::Gemm g{A, Bt, M, N, K}; pg8::StaticOrder S; S.init(M, N, G, ((int)blockIdx.x + G - (rot % G)) % G);
    pg8::gemm_phase<Epi, pg8::StaticOrder, true, true>(lds, g, S, E);
}

__device__ __forceinline__ bool tr_job(int& r, const float* W, int ldw, int K, int col_off, int ncols, bf16_t* WT, const float* normw, int climit, float cscale, LAS float* scr, int lane) {
    const int nblk = ncols / 64, items = (K / 64) * nblk;
    if (r >= items) { r -= items; return false; }
    const int kb = r / nblk, nb = r % nblk, k0 = 64 * kb, n0 = 64 * nb;
    f32x4 v[16];
#pragma unroll
    for (int i = 0; i < 16; ++i) { const int kk = 4 * i + (lane >> 4); v[i] = *(const f32x4*)(W + (size_t)(k0 + kk) * ldw + col_off + n0 + (lane & 15) * 4); }
#pragma unroll
    for (int i = 0; i < 16; ++i) { const int kk = 4 * i + (lane >> 4); const float nw = normw ? normw[k0 + kk] : 1.f; LAS float* d = scr + kk * 65 + (lane & 15) * 4;
        d[0] = v[i][0] * nw; d[1] = v[i][1] * nw; d[2] = v[i][2] * nw; d[3] = v[i][3] * nw; }
    asm volatile("s_waitcnt lgkmcnt(0)" ::: "memory");
    const int c = lane & 7;
#pragma unroll
    for (int j = 0; j < 8; ++j) { const int n = (lane >> 3) + 8 * j; const LAS float* sp = scr + (8 * c) * 65 + n; const float sc = (n0 + n) < climit ? cscale : 1.f;
        u32x4 o; o.x = pk2(sp[0 * 65] * sc, sp[1 * 65] * sc); o.y = pk2(sp[2 * 65] * sc, sp[3 * 65] * sc); o.z = pk2(sp[4 * 65] * sc, sp[5 * 65] * sc); o.w = pk2(sp[6 * 65] * sc, sp[7 * 65] * sc);
        *(u32x4*)(WT + (size_t)(n0 + n) * K + k0 + 8 * c) = o; }
    asm volatile("s_waitcnt lgkmcnt(0)" ::: "memory");
    return true;
}
__device__ __forceinline__ void cvt_flat(const float* src, bf16_t* dst, size_t n8, size_t gtid, size_t gthreads) {
    for (size_t i = gtid; i < n8; i += gthreads) { const f32x4 a = *(const f32x4*)(src + i * 8), b = *(const f32x4*)(src + i * 8 + 4);
        u32x4 w; w.x = pk2(a[0], a[1]); w.y = pk2(a[2], a[3]); w.z = pk2(b[0], b[1]); w.w = pk2(b[2], b[3]); *(u32x4*)(dst + i * 8) = w; }
}
typedef float f32x2 __attribute__((ext_vector_type(2)));
__device__ __forceinline__ void cvt_rows_fp8(const float* src, unsigned char* dst, float* inv, int rbeg, int nrows, int gw, int NGW, int lane, const int bias) {
    for (int r0 = rbeg + gw; r0 < nrows; r0 += 2 * NGW) {
        f32x4 v[2][8];
#pragma unroll
        for (int u = 0; u < 2; ++u) { const int r = r0 + u * NGW; if (r < nrows) { const f32x4* xr = (const f32x4*)(src + (size_t)r * 2048) + lane;
#pragma unroll
            for (int j = 0; j < 8; ++j) v[u][j] = xr[64 * j]; } }
#pragma unroll
        for (int u = 0; u < 2; ++u) { const int r = r0 + u * NGW; if (r < nrows) {
            float am = 0.f;
#pragma unroll
            for (int j = 0; j < 8; ++j) am = fmaxf(am, fmaxf(fmaxf(fabsf(v[u][j][0]), fabsf(v[u][j][1])), fmaxf(fabsf(v[u][j][2]), fabsf(v[u][j][3]))));
#pragma unroll
            for (int o = 1; o < 64; o <<= 1) am = fmaxf(am, __shfl_xor(am, o));
            const float sc = am > 0.f ? 127.0f / am : 0.f;
            const int layer = r >> 14, rl = r & 16383;
#pragma unroll
            for (int j = 0; j < 8; ++j) {
                const unsigned u0 = (unsigned)((int)rintf(v[u][j][0] * sc) + bias) & 255u, u1 = (unsigned)((int)rintf(v[u][j][1] * sc) + bias) & 255u, u2 = (unsigned)((int)rintf(v[u][j][2] * sc) + bias) & 255u, u3 = (unsigned)((int)rintf(v[u][j][3] * sc) + bias) & 255u;
                *(unsigned*)(dst + ((size_t)(layer * 16 + 2 * j + (lane >> 5)) * 16384 + rl) * 128 + 4 * (lane & 31)) = u0 | (u1 << 8) | (u2 << 16) | (u3 << 24); }
            if (lane == 0) inv[r] = am * (1.0f / 127.0f);
        } }
    }
}
__device__ __forceinline__ void p0_prologue(const Params& p, LAS unsigned char* lds) {
    const int tid = threadIdx.x, lane = tid & 63, wave = tid >> 6;
    const int gw = blockIdx.x * 8 + wave, NGW = gridDim.x * 8;
    unsigned char* ws = p.ws;
    LAS float* GT = (LAS float*)lds;
    for (int i = tid; i < 2048 * 8; i += 512) { const int k = i >> 3, g = i & 7; GT[i] = p.in[2][k] * p.in[3][(size_t)k * 6152 + 6144 + g]; }
    BLOCK_SYNC();
    { float* SS = (float*)(ws + WS_SS); float* GATES = (float*)(ws + WS_GATES); bf16_t* HBA = (bf16_t*)(ws + WS_HBA);
      for (int m = gw; m < T; m += NGW) {
        const f32x4* xr = (const f32x4*)(p.in[0] + (size_t)m * D) + lane;
        f32x4 v[8]; float s = 0.f;
#pragma unroll
        for (int j = 0; j < 8; ++j) { v[j] = xr[64 * j]; s += (v[j][0] * v[j][0] + v[j][1] * v[j][1]) + (v[j][2] * v[j][2] + v[j][3] * v[j][3]); }
        s = wave_sum(s);
        const float rs = rstd_of(s);
        float ga[8];
#pragma unroll
        for (int g = 0; g < 8; ++g) ga[g] = 0.f;
#pragma unroll
        for (int j = 0; j < 8; ++j) {
            *(u32x2*)(HBA + (size_t)m * D + 256 * j + 4 * lane) = (u32x2){pk2(v[j][0], v[j][1]), pk2(v[j][2], v[j][3])};
#pragma unroll
            for (int e = 0; e < 4; ++e) { const int k = 256 * j + 4 * lane + e; const f32x4 g0 = *(const LAS f32x4*)(GT + k * 8), g1 = *(const LAS f32x4*)(GT + k * 8 + 4); const float xv = v[j][e];
                ga[0] += xv * g0[0]; ga[1] += xv * g0[1]; ga[2] += xv * g0[2]; ga[3] += xv * g0[3]; ga[4] += xv * g1[0]; ga[5] += xv * g1[1]; ga[6] += xv * g1[2]; ga[7] += xv * g1[3]; }
        }
#pragma unroll
        for (int g = 0; g < 8; ++g) ga[g] = wave_sum(ga[g]) * rs;
        if (lane == 0) { SS[m] = s; *(f32x4*)(GATES + (size_t)m * 8) = (f32x4){ga[0], ga[1], ga[2], ga[3]}; *(f32x4*)(GATES + (size_t)m * 8 + 4) = (f32x4){ga[4], ga[5], ga[6], ga[7]}; }
      } }
    BLOCK_SYNC();
    { LAS float* scr = (LAS float*)(lds + wave * 16640);
      const bool split = (gridDim.x == 256);
      const int NITEMS = 32 * 96 + 32 * 32 + 32 * 32 + 32 * 4 + 32 * 4 + 32 * 32 + 2 * 32 * 32 + 2 * 32 * 32 + 2 * 4 * 32 - (split ? 3 * 32 * 32 : 0);
      for (int it = gw; it < NITEMS; it += NGW) {
        int r = it;
        if (tr_job(r, p.in[3], 6152, 2048, 0, 6144, (bf16_t*)(ws + WS_WIN), p.in[2], 1024, 0.0625f, scr, lane)) continue;
        if (tr_job(r, p.in[6], 2048, 2048, 0, 2048, (bf16_t*)(ws + WS_WOUT), nullptr, 0, 1.f, scr, lane)) continue;
        if (tr_job(r, p.in[10], 2048, 2048, 0, 2048, (bf16_t*)(ws + WS_WQKV), p.in[9], 2048, 0.125f, scr, lane)) continue;
        if (tr_job(r, p.in[8], 512, 2048, 0, 256, (bf16_t*)(ws + WS_WQKV) + (size_t)2048 * 2048, p.in[7], 0, 1.f, scr, lane)) continue;
        if (tr_job(r, p.in[8], 512, 2048, 256, 256, (bf16_t*)(ws + WS_WQKV) + (size_t)2304 * 2048, p.in[7], 0, 1.f, scr, lane)) continue;
        if (!split) if (tr_job(r, p.in[12], 2048, 2048, 0, 2048, (bf16_t*)(ws + WS_WO), nullptr, 0, 1.f, scr, lane)) continue;
        if (tr_job(r, p.in[14], 2048, 2048, 0, 2048, (bf16_t*)(ws + WS_WPQ), p.in[13], 0, 1.f, scr, lane)) continue;
        if (!split) if (tr_job(r, p.in[14] + (size_t)D * D, 2048, 2048, 0, 2048, (bf16_t*)(ws + WS_WPQ) + (size_t)D * D, p.in[13] + D, 0, 1.f, scr, lane)) continue;
        if (tr_job(r, p.in[20], 2048, 2048, 0, 2048, (bf16_t*)(ws + WS_WG), p.in[19], 0, 1.f, scr, lane)) continue;
        if (!split) if (tr_job(r, p.in[20] + (size_t)D * D, 2048, 2048, 0, 2048, (bf16_t*)(ws + WS_WG) + (size_t)D * D, p.in[19] + D, 0, 1.f, scr, lane)) continue;
        if (tr_job(r, p.in[21], 2048, 256, 0, 2048, (bf16_t*)(ws + WS_WPR), nullptr, 0, 1.f, scr, lane)) continue;
        tr_job(r, p.in[21] + (size_t)256 * D, 2048, 256, 0, 2048, (bf16_t*)(ws + WS_WPR) + (size_t)D * 256, nullptr, 0, 1.f, scr, lane);
      } }
    { const size_t gtid = (size_t)blockIdx.x * 512 + tid, gth = (size_t)gridDim.x * 512;
      const int nconv = (gridDim.x == 256) ? 16384 : 2 * 16384;
      cvt_rows_fp8(p.in[17], ws + WS_UB, (float*)(ws + WS_USC), 0, nconv, gw, NGW, lane, 0);
      cvt_rows_fp8(p.in[18], ws + WS_VB, (float*)(ws + WS_VSC), 0, nconv, gw, NGW, lane, 0);
      cvt_flat(p.in[1], (bf16_t*)(ws + WS_PB), (size_t)2 * T * 256 / 8, gtid, gth);
      cvt_flat(p.in[15], (bf16_t*)(ws + WS_K1), (size_t)2 * 8 * 128 * 128 / 8, gtid, gth);
      cvt_flat(p.in[16], (bf16_t*)(ws + WS_K2), (size_t)2 * 8 * 128 * 128 / 8, gtid, gth); }
}

__device__ __forceinline__ float block_scan_add(float v, LAS float* red, int tid) {
    const int lane = tid & 63, wave = tid >> 6; float inc = v;
#pragma unroll
    for (int o = 1; o < 64; o <<= 1) { const float t = __shfl_up(inc, o); if (lane >= o) inc += t; }
    BLOCK_SYNC(); if (lane == 63) red[wave] = inc; BLOCK_SYNC();
    float off = 0.f; for (int w = 0; w < wave; ++w) off += red[w];
    return off + inc - v;
}
__device__ __forceinline__ float block_scan_max(float v, LAS float* red, int tid) {
    const int lane = tid & 63, wave = tid >> 6; float inc = v;
#pragma unroll
    for (int o = 1; o < 64; o <<= 1) { const float t = __shfl_up(inc, o); if (lane >= o) inc = fmaxf(inc, t); }
    BLOCK_SYNC(); if (lane == 63) red[wave] = inc; BLOCK_SYNC();
    float off = -INFINITY; for (int w = 0; w < wave; ++w) off = fmaxf(off, red[w]);
    const float prev = __shfl_up(inc, 1);
    return fmaxf(off, lane == 0 ? -INFINITY : prev);
}
__device__ __forceinline__ float softcap(float t) { return 15.0f * tanhf(t * (1.0f / 15.0f)); }
__device__ __forceinline__ float logsigmoid(float x) { return x >= 0.f ? -log1pf(expf(-x)) : x - log1pf(expf(x)); }
__device__ __forceinline__ void gate_prefix(const Params& p, LAS unsigned char* lds, int seq) {
    const int tid = threadIdx.x; const int b = seq >> 2, h = seq & 3;
    const float* GATES = (const float*)(p.ws + WS_GATES); const float* gb = p.in[4];
    float* AA = (float*)(p.ws + WS_AA) + seq * SEQ; float* MMp = (float*)(p.ws + WS_MM) + seq * SEQ; float* FFp = (float*)(p.ws + WS_FF) + seq * SEQ;
    LAS float* red = (LAS float*)lds;
    float li[16], lf[16]; float run = 0.f;
#pragma unroll
    for (int i = 0; i < 16; ++i) { const int t = tid * 16 + i; const size_t row = (size_t)b * SEQ + t;
        li[i] = softcap(GATES[row * 8 + h] + gb[h]); run += logsigmoid(softcap(GATES[row * 8 + 4 + h] + gb[4 + h])); lf[i] = run; }
    const float off = block_scan_add(run, red, tid);
    float cm = -INFINITY;
#pragma unroll
    for (int i = 0; i < 16; ++i) { lf[i] += off; li[i] = li[i] - lf[i]; cm = fmaxf(cm, li[i]); }
    const float offm = fmaxf(0.f, block_scan_max(cm, red + 16, tid));
    float rm = offm;
#pragma unroll
    for (int i = 0; i < 16; ++i) { const int t = tid * 16 + i; rm = fmaxf(rm, li[i]); AA[t] = li[i]; MMp[t] = rm; FFp[t] = lf[i]; }
    BLOCK_SYNC();
}

constexpr int ML_Q = 0, ML_K = 33792, ML_P = 67584, ML_VTW = 76800, ML_VT = 86016, ML_GT = 95232, ML_VEC = 129024;
__device__ __forceinline__ void mlstm_item(const Params& p, LAS unsigned char* lds, int seq, int slice, int seg, bool full) {
    const int tid = threadIdx.x, lane = tid & 63, w = tid >> 6, fr = lane & 15, g = lane >> 4;
    const int b = seq >> 2, h = seq & 3;
    unsigned char* ws = p.ws;
    const bf16_t* QK = (const bf16_t*)(ws + WS_QK); const bf16_t* VTg = (const bf16_t*)(ws + WS_KVT); bf16_t* HM = (bf16_t*)(ws + WS_HM);
    const float* AA = (const float*)(ws + WS_AA) + seq * SEQ; const float* MMp = (const float*)(ws + WS_MM) + seq * SEQ; const float* FFp = (const float*)(ws + WS_FF) + seq * SEQ;
    float* SEGST = (float*)(ws + WS_SEGST); float* SEGN = (float*)(ws + WS_SEGN);
    LAS float* Av = (LAS float*)(lds + ML_VEC); LAS float* Mv = Av + 64; LAS float* Fv = Av + 128; LAS float* Wv = Av + 192; LAS float* QN = Av + 256; LAS float* DENP = Av + 320; LAS float* NV = Av + 576;
    f32x4 accG[4][2];
#pragma unroll
    for (int dvt = 0; dvt < 4; ++dvt)
#pragma unroll
        for (int a = 0; a < 2; ++a) accG[dvt][a] = (f32x4){0.f, 0.f, 0.f, 0.f};
    float nreg[2] = {0.f, 0.f};
    if (full && seg > 0) {
        const float Mref = MMp[seg * CSEG * 64 - 1];
        for (int s2 = 0; s2 < seg; ++s2) {
            const float sc = expf(MMp[(s2 + 1) * CSEG * 64 - 1] - Mref);
            const float* st = SEGST + ((size_t)((seq * NSEG + s2) * 8 + slice)) * 16384;
#pragma unroll
            for (int dvt = 0; dvt < 4; ++dvt)
#pragma unroll
                for (int a = 0; a < 2; ++a) accG[dvt][a] += *(const f32x4*)(st + ((2 * w + a) * 16 + fr) * 64 + dvt * 16 + g * 4) * sc;
#pragma unroll
            for (int a = 0; a < 2; ++a) nreg[a] += sc * SEGN[(seq * NSEG + s2) * 256 + (2 * w + a) * 16 + fr];
        }
    }
    if (g == 0) { NV[(2 * w) * 16 + fr] = nreg[0]; NV[(2 * w + 1) * 16 + fr] = nreg[1]; }
#define ML_GT_WRITE() do { _Pragma("unroll") for (int dvt = 0; dvt < 4; ++dvt) _Pragma("unroll") for (int a = 0; a < 2; ++a) { \
        const unsigned lo_ = pk2(accG[dvt][a][0], accG[dvt][a][1]), hi_ = pk2(accG[dvt][a][2], accG[dvt][a][3]); \
        LAS unsigned char* gp_ = lds + ML_GT + (dvt * 16 + g * 4) * 528 + ((2 * w + a) * 16 + fr) * 2; \
        *(LAS bf16_t*)(gp_) = (bf16_t)(lo_ & 0xffffu); *(LAS bf16_t*)(gp_ + 528) = (bf16_t)(lo_ >> 16); *(LAS bf16_t*)(gp_ + 2 * 528) = (bf16_t)(hi_ & 0xffffu); *(LAS bf16_t*)(gp_ + 3 * 528) = (bf16_t)(hi_ >> 16); } } while (0)
    ML_GT_WRITE();
    const int c0 = seg * CSEG, c1 = c0 + CSEG;
#define ML_BAR() do { asm volatile("s_waitcnt lgkmcnt(0)" ::: "memory"); __builtin_amdgcn_s_barrier(); asm volatile("" ::: "memory"); } while (0)
    u32x4 pkk[4], pvt; float pa = 0.f, pmv = 0.f, pf = 0.f, pMprev = 0.f, pMend = 0.f;
#define ML_ISSUE_KV(cc_) do { const int c_ = (cc_); const size_t tk_ = (size_t)b * SEQ + (size_t)c_ * 64; \
        if (!full) { _Pragma("unroll") for (int i = 0; i < 4; ++i) { const int q_ = tid + 512 * i, row_ = q_ >> 5, c8_ = q_ & 31; pkk[i] = *(const u32x4*)(QK + (tk_ + row_) * 2048 + 1024 + h * 256 + c8_ * 8); } } \
        { const int row_ = tid >> 3, c8_ = tid & 7; pvt = *(const u32x4*)(VTg + (size_t)(h * 512 + slice * 64 + row_) * T + tk_ + c8_ * 8); } \
        if (tid < 64) { pa = AA[c_ * 64 + tid]; pmv = MMp[c_ * 64 + tid]; pf = FFp[c_ * 64 + tid]; } \
        pMprev = (c_ == 0) ? 0.f : MMp[c_ * 64 - 1]; pMend = MMp[c_ * 64 + 63]; } while (0)
    ML_ISSUE_KV(c0);
    BLOCK_SYNC();
    for (int c = c0; c < c1; ++c) {
        const size_t tok0 = (size_t)b * SEQ + (size_t)c * 64;
        if (full) {
#pragma unroll
            for (int i = 0; i < 4; ++i) { const int q = tid + 512 * i, row = q >> 5, cc = q & 31;
                const u32x4 vq = *(const u32x4*)(QK + (tok0 + row) * 2048 + h * 256 + cc * 8);
                const u32x4 vk = *(const u32x4*)(QK + (tok0 + row) * 2048 + 1024 + h * 256 + cc * 8);
                *(LAS u32x4*)(lds + ML_Q + row * 528 + cc * 16) = vq; *(LAS u32x4*)(lds + ML_K + row * 528 + cc * 16) = vk; }
        } else {
#pragma unroll
            for (int i = 0; i < 4; ++i) { const int q = tid + 512 * i, row = q >> 5, cc = q & 31; *(LAS u32x4*)(lds + ML_K + row * 528 + cc * 16) = pkk[i]; }
        }
        { const int row = tid >> 3, cc = tid & 7; *(LAS u32x4*)(lds + ML_VT + row * 144 + cc * 16) = pvt; }
        if (tid < 64) { Av[tid] = pa; Mv[tid] = pmv; Fv[tid] = pf; }
        const float Mprev = pMprev, Mend = pMend;
        if (c + 1 < c1) ML_ISSUE_KV(c + 1);
        ML_BAR();
        if (tid < 64) Wv[tid] = expf(Av[tid] - Mend);
        f32x4 sacc[2];
        const int jt = w >> 1, tt0 = 2 * (w & 1);
        if (full) {
#pragma unroll
            for (int u = 0; u < 2; ++u) { sacc[u] = (f32x4){0.f, 0.f, 0.f, 0.f}; const int tt = tt0 + u;
                if (jt <= tt) {
#pragma unroll
                    for (int ks = 0; ks < 8; ++ks) sacc[u] = mfma16(lfrag(lds + ML_K, jt * 16 + fr, 528, ks * 64 + g * 16), lfrag(lds + ML_Q, tt * 16 + fr, 528, ks * 64 + g * 16), sacc[u]);
                } }
        }
        ML_BAR();
        { const int row = tid >> 3, cc = tid & 7;
            const u32x4 v = *(const LAS u32x4*)(lds + ML_VT + row * 144 + cc * 16); const LAS float* wj = Wv + cc * 8;
            u32x4 o; o.x = pk2(bflo(v.x) * wj[0], bfhi(v.x) * wj[1]); o.y = pk2(bflo(v.y) * wj[2], bfhi(v.y) * wj[3]); o.z = pk2(bflo(v.z) * wj[4], bfhi(v.z) * wj[5]); o.w = pk2(bflo(v.w) * wj[6], bfhi(v.w) * wj[7]);
            *(LAS u32x4*)(lds + ML_VTW + row * 144 + cc * 16) = o; }
        if (full) {
#pragma unroll
            for (int u = 0; u < 2; ++u) { const int tt = tt0 + u, t = tt * 16 + fr; const float Mt = Mv[t]; float pv[4]; float rsum = 0.f;
#pragma unroll
                for (int i = 0; i < 4; ++i) { const int j = jt * 16 + g * 4 + i; pv[i] = (j <= t) ? sacc[u][i] * __expf(Av[j] - Mt) : 0.f; rsum += pv[i]; }
                rsum += __shfl_xor(rsum, 16); rsum += __shfl_xor(rsum, 32);
                if (g == 0) DENP[jt * 64 + t] = rsum;
                *(LAS u32x2*)(lds + ML_P + t * 144 + (jt * 16 + g * 4) * 2) = (u32x2){pk2(pv[0], pv[1]), pk2(pv[2], pv[3])}; }
            { const int t = tid >> 3, part = tid & 7; float sq = 0.f;
#pragma unroll
                for (int i = 0; i < 4; ++i) { const u32x4 qv = *(const LAS u32x4*)(lds + ML_Q + t * 528 + part * 64 + i * 16); const LAS float* nn = NV + part * 32 + i * 8;
                    sq += bflo(qv.x) * nn[0] + bfhi(qv.x) * nn[1] + bflo(qv.y) * nn[2] + bfhi(qv.y) * nn[3] + bflo(qv.z) * nn[4] + bfhi(qv.z) * nn[5] + bflo(qv.w) * nn[6] + bfhi(qv.w) * nn[7]; }
                sq += __shfl_xor(sq, 1); sq += __shfl_xor(sq, 2); sq += __shfl_xor(sq, 4);
                if (part == 0) QN[t] = sq; }
        }
        ML_BAR();
        if (full) {
            const int tt = w >> 1, dvt0 = 2 * (w & 1);
            f32x4 a1[2], a2[2];
#pragma unroll
            for (int u = 0; u < 2; ++u) { a1[u] = (f32x4){0.f, 0.f, 0.f, 0.f}; a2[u] = (f32x4){0.f, 0.f, 0.f, 0.f}; }
#pragma unroll
            for (int ks = 0; ks < 8; ++ks) { const bf16x8 a = lfrag(lds + ML_Q, tt * 16 + fr, 528, ks * 64 + g * 16);
#pragma unroll
                for (int u = 0; u < 2; ++u) a1[u] = mfma16(a, lfrag(lds + ML_GT, (dvt0 + u) * 16 + fr, 528, ks * 64 + g * 16), a1[u]); }
#pragma unroll
            for (int ks = 0; ks < 2; ++ks) { const bf16x8 a = lfrag(lds + ML_P, tt * 16 + fr, 144, ks * 64 + g * 16);
#pragma unroll
                for (int u = 0; u < 2; ++u) a2[u] = mfma16(a, lfrag(lds + ML_VT, (dvt0 + u) * 16 + fr, 144, ks * 64 + g * 16), a2[u]); }
#pragma unroll
            for (int i = 0; i < 4; ++i) { const int t = tt * 16 + g * 4 + i; const float Mt = Mv[t]; const float wi = __expf(Mprev - Mt);
                const float den = wi * QN[t] + ((DENP[t] + DENP[64 + t]) + (DENP[128 + t] + DENP[192 + t]));
                const float inv = 1.0f / fmaxf(fabsf(den), __expf(-(Fv[t] + Mt)));
#pragma unroll
                for (int u = 0; u < 2; ++u) { const float hv = (wi * a1[u][i] + a2[u][i]) * inv;
                    HM[(tok0 + t) * 2048 + h * 512 + slice * 64 + (dvt0 + u) * 16 + fr] = (bf16_t)(pk2(hv, 0.f) & 0xffffu); } }
        }
        { const float decay = expf(Mprev - Mend);
#pragma unroll
            for (int dvt = 0; dvt < 4; ++dvt)
#pragma unroll
                for (int a = 0; a < 2; ++a) accG[dvt][a] = accG[dvt][a] * decay;
            f32x4 accN[2] = {(f32x4){0.f, 0.f, 0.f, 0.f}, (f32x4){0.f, 0.f, 0.f, 0.f}};
#pragma unroll
            for (int ks = 0; ks < 2; ++ks) {
                bf16x8 kf[2];
#pragma unroll
                for (int a = 0; a < 2; ++a) { const LAS unsigned char* kp = lds + ML_K + (ks * 32 + g * 8) * 528 + ((2 * w + a) * 16 + fr) * 2;
                    const unsigned e0 = *(const LAS bf16_t*)(kp), e1 = *(const LAS bf16_t*)(kp + 528), e2 = *(const LAS bf16_t*)(kp + 2 * 528), e3 = *(const LAS bf16_t*)(kp + 3 * 528);
                    const unsigned e4 = *(const LAS bf16_t*)(kp + 4 * 528), e5 = *(const LAS bf16_t*)(kp + 5 * 528), e6 = *(const LAS bf16_t*)(kp + 6 * 528), e7 = *(const LAS bf16_t*)(kp + 7 * 528);
                    kf[a] = __builtin_bit_cast(bf16x8, (u32x4){e0 | (e1 << 16), e2 | (e3 << 16), e4 | (e5 << 16), e6 | (e7 << 16)}); }
                const LAS float* wp = Wv + ks * 32 + g * 8;
                u32x4 wq = (u32x4){pk2(wp[0], wp[1]), pk2(wp[2], wp[3]), pk2(wp[4], wp[5]), pk2(wp[6], wp[7])};
                if (fr != 0) wq = (u32x4){0u, 0u, 0u, 0u};
                const bf16x8 wf = __builtin_bit_cast(bf16x8, wq);
#pragma unroll
                for (int dvt = 0; dvt < 4; ++dvt) { const bf16x8 vb = lfrag(lds + ML_VTW, dvt * 16 + fr, 144, ks * 64 + g * 16);
                    accG[dvt][0] = mfma16(vb, kf[0], accG[dvt][0]); accG[dvt][1] = mfma16(vb, kf[1], accG[dvt][1]); }
                accN[0] = mfma16(wf, kf[0], accN[0]); accN[1] = mfma16(wf, kf[1], accN[1]);
            }
            nreg[0] = decay * nreg[0] + accN[0][0]; nreg[1] = decay * nreg[1] + accN[1][0]; }
        ML_BAR();
        if (g == 0) { NV[(2 * w) * 16 + fr] = nreg[0]; NV[(2 * w + 1) * 16 + fr] = nreg[1]; }
        if (full) ML_GT_WRITE();
    }
    if (!full) {
        float* st = SEGST + ((size_t)((seq * NSEG + seg) * 8 + slice)) * 16384;
#pragma unroll
        for (int dvt = 0; dvt < 4; ++dvt)
#pragma unroll
            for (int a = 0; a < 2; ++a) *(f32x4*)(st + ((2 * w + a) * 16 + fr) * 64 + dvt * 16 + g * 4) = accG[dvt][a];
        if (slice == 0 && g == 0) { SEGN[(seq * NSEG + seg) * 256 + (2 * w) * 16 + fr] = nreg[0]; SEGN[(seq * NSEG + seg) * 256 + (2 * w + 1) * 16 + fr] = nreg[1]; }
    }
    BLOCK_SYNC();
#undef ML_GT_WRITE
}

__device__ __forceinline__ void headnorm_phase(const Params& p) {
    const int lane = threadIdx.x & 63, gw = blockIdx.x * 8 + (threadIdx.x >> 6), NGW = gridDim.x * 8;
    const bf16_t* HM = (const bf16_t*)(p.ws + WS_HM); const bf16_t* OG = (const bf16_t*)(p.ws + WS_OG); bf16_t* HG = (bf16_t*)(p.ws + WS_QK);
    const float* hn = p.in[5];
    for (int it0 = gw; it0 < T * 4; it0 += 4 * NGW) {
        u32x4 hv[4], ov[4];
#pragma unroll
        for (int u = 0; u < 4; ++u) { const int it = it0 + u * NGW; if (it < T * 4) { const size_t off = (size_t)(it >> 2) * 2048 + (it & 3) * 512 + lane * 8; hv[u] = *(const u32x4*)(HM + off); ov[u] = *(const u32x4*)(OG + off); } }
#pragma unroll
        for (int u = 0; u < 4; ++u) { const int it = it0 + u * NGW; if (it < T * 4) {
            const size_t off = (size_t)(it >> 2) * 2048 + (it & 3) * 512 + lane * 8;
            float x[8] = {bflo(hv[u].x), bfhi(hv[u].x), bflo(hv[u].y), bfhi(hv[u].y), bflo(hv[u].z), bfhi(hv[u].z), bflo(hv[u].w), bfhi(hv[u].w)};
            float o[8] = {bflo(ov[u].x), bfhi(ov[u].x), bflo(ov[u].y), bfhi(ov[u].y), bflo(ov[u].z), bfhi(ov[u].z), bflo(ov[u].w), bfhi(ov[u].w)};
            float sq = 0.f;
#pragma unroll
            for (int i = 0; i < 8; ++i) sq += x[i] * x[i];
            sq = wave_sum(sq);
            const float rs = 1.0f / sqrtf(sq * (1.0f / 512.0f) + EPS);
            const f32x4 n0 = *(const f32x4*)(hn + (it & 3) * 512 + lane * 8), n1 = *(const f32x4*)(hn + (it & 3) * 512 + lane * 8 + 4);
            float y[8];
#pragma unroll
            for (int i = 0; i < 8; ++i) y[i] = x[i] * rs * (i < 4 ? n0[i] : n1[i - 4]) * sigmoidf_(o[i]);
            *(u32x4*)(HG + off) = (u32x4){pk2(y[0], y[1]), pk2(y[2], y[3]), pk2(y[4], y[5]), pk2(y[6], y[7])};
        } }
    }
}

__device__ __forceinline__ void bsort16(unsigned (&v)[16]) {
#pragma unroll
    for (int k = 2; k <= 16; k <<= 1)
#pragma unroll
        for (int j = k >> 1; j > 0; j >>= 1)
#pragma unroll
            for (int i = 0; i < 16; ++i) { const int l = i ^ j; if (l > i) { const bool up = ((i & k) == 0); const unsigned hi = max(v[i], v[l]), lo = min(v[i], v[l]); v[i] = up ? hi : lo; v[l] = up ? lo : hi; } }
}
__device__ __forceinline__ void bmerge16(unsigned (&a)[16], const unsigned (&b)[16]) {
#pragma unroll
    for (int i = 0; i < 16; ++i) a[i] = max(a[i], b[15 - i]);
#pragma unroll
    for (int j = 8; j > 0; j >>= 1)
#pragma unroll
        for (int i = 0; i < 16; ++i) { const int l = i ^ j; if (l > i) { const unsigned hi = max(a[i], a[l]), lo = min(a[i], a[l]); a[i] = hi; a[l] = lo; } }
}
__device__ __forceinline__ unsigned f2ord(float s) { const unsigned u = __float_as_uint(s); return (u & 0x80000000u) ? ~u : (u | 0x80000000u); }
__device__ __forceinline__ void peer_topk(const Params& p, LAS unsigned char* lds, int layer, const SSRef ssin) {
    const int tid = threadIdx.x, lane = tid & 63, w = tid >> 6, fr = lane & 15, g = lane >> 4;
    const bf16_t* QP = (const bf16_t*)(p.ws + WS_QK); int* EIDX = (int*)(p.ws + WS_EIDX); float* GW = (float*)(p.ws + WS_GW);
    LAS float* SC = (LAS float*)lds;
    LAS float* TV = SC + 4 * 128 * 65;
    LAS unsigned char* TI = (LAS unsigned char*)(TV + 4 * 16 * 64);
    for (int item = blockIdx.x; item < 1024; item += gridDim.x) {
        const int hp = item & 3, t0 = (item >> 2) * 64;
        { const int hs = w >> 2, half = (w >> 1) & 1, nt0 = 4 * (w & 1), h = hp * 2 + hs;
          const bf16_t* KB = (const bf16_t*)(p.ws + (half ? WS_K2 : WS_K1)) + (size_t)(layer * 8 + h) * 128 * 128;
          f32x4 acc[4][4];
#pragma unroll
          for (int u = 0; u < 4; ++u)
#pragma unroll
              for (int tt = 0; tt < 4; ++tt) acc[u][tt] = (f32x4){0.f, 0.f, 0.f, 0.f};
#pragma unroll
          for (int ks = 0; ks < 4; ++ks) {
              bf16x8 a[4], bq[4];
#pragma unroll
              for (int u = 0; u < 4; ++u) a[u] = *(const bf16x8*)(KB + ((nt0 + u) * 16 + fr) * 128 + ks * 32 + g * 8);
#pragma unroll
              for (int tt = 0; tt < 4; ++tt) bq[tt] = *(const bf16x8*)(QP + (size_t)(t0 + tt * 16 + fr) * 2048 + h * 256 + half * 128 + ks * 32 + g * 8);
#pragma unroll
              for (int u = 0; u < 4; ++u)
#pragma unroll
                  for (int tt = 0; tt < 4; ++tt) acc[u][tt] = mfma16(a[u], bq[tt], acc[u][tt]);
          }
#pragma unroll
          for (int u = 0; u < 4; ++u)
#pragma unroll
              for (int tt = 0; tt < 4; ++tt)
#pragma unroll
                  for (int i = 0; i < 4; ++i) SC[((hs * 2 + half) * 128 + (nt0 + u) * 16 + g * 4 + i) * 65 + tt * 16 + fr] = acc[u][tt][i];
        }
        BLOCK_SYNC();
        if (tid < 256) {
            const int t = tid & 63, lh = tid >> 6;
            unsigned L[16];
#pragma unroll
            for (int i = 0; i < 16; ++i) L[i] = (f2ord(SC[(lh * 128 + i) * 65 + t]) & ~0x7Fu) | (unsigned)(127 - i);
            bsort16(L);
            for (int gi = 1; gi < 8; ++gi) {
                unsigned B[16];
#pragma unroll
                for (int i = 0; i < 16; ++i) { const int n = gi * 16 + i; B[i] = (f2ord(SC[(lh * 128 + n) * 65 + t]) & ~0x7Fu) | (unsigned)(127 - n); }
                bsort16(B); bmerge16(L, B);
            }
#pragma unroll
            for (int i = 0; i < 16; ++i) { const int n = 127 - (int)(L[i] & 0x7Fu); TV[(lh * 16 + i) * 64 + t] = SC[(lh * 128 + n) * 65 + t]; TI[(lh * 16 + i) * 64 + t] = (unsigned char)n; }
        }
        BLOCK_SYNC();
        if (tid < 128) {
            const int t = tid & 63, hs = tid >> 6, h = hp * 2 + hs;
            const LAS float* TV1 = TV + (hs * 2) * 16 * 64; const LAS float* TV2 = TV1 + 16 * 64;
            const LAS unsigned char* TI1 = TI + (hs * 2) * 16 * 64; const LAS unsigned char* TI2 = TI1 + 16 * 64;
            float v2[16];
#pragma unroll
            for (int bq = 0; bq < 16; ++bq) v2[bq] = TV2[bq * 64 + t];
            float v1[16];
#pragma unroll
            for (int a = 0; a < 16; ++a) v1[a] = TV1[a * 64 + t];
            unsigned C[4][16];
            { int cnt = 0;
#pragma unroll
              for (int a = 0; a < 16; ++a)
#pragma unroll
                  for (int bq = 0; bq < 16; ++bq) if ((a + 1) * (bq + 1) <= 16) { C[cnt >> 4][cnt & 15] = (f2ord(v1[a] + v2[bq]) & ~0xFFu) | (unsigned)(255 - (a * 16 + bq)); ++cnt; }
#pragma unroll
              for (int c2 = 50; c2 < 64; ++c2) C[c2 >> 4][c2 & 15] = 0u; }
            bsort16(C[0]); bsort16(C[1]); bsort16(C[2]); bsort16(C[3]);
            bmerge16(C[0], C[1]); bmerge16(C[2], C[3]); bmerge16(C[0], C[2]);
            unsigned (&L)[16] = C[0];
            float sv[16]; int e[16]; float mx = -INFINITY;
#pragma unroll
            for (int i = 0; i < 16; ++i) { const int flat = 255 - (int)(L[i] & 0xFFu), a = flat >> 4, bq = flat & 15;
                sv[i] = TV1[a * 64 + t] + TV2[bq * 64 + t]; e[i] = (int)TI1[a * 64 + t] * 128 + (int)TI2[bq * 64 + t]; mx = fmaxf(mx, sv[i]); }
            float sum = 0.f;
#pragma unroll
            for (int i = 0; i < 16; ++i) { sv[i] = __expf(sv[i] - mx); sum += sv[i]; }
            const float inv = 1.0f / sum;
#pragma unroll
            for (int i = 0; i < 16; i += 4) {
#pragma unroll
                for (int k2 = 0; k2 < 4; ++k2) { const int sl_ = h * 16 + i + k2; EIDX[(size_t)(t0 + t) * 128 + (sl_ & 7) * 16 + (sl_ >> 3)] = e[i + k2]; }
                *(f32x4*)(GW + (size_t)(t0 + t) * 128 + h * 16 + i) = (f32x4){sv[i] * inv, sv[i + 1] * inv, sv[i + 2] * inv, sv[i + 3] * inv};
            }
        }
        BLOCK_SYNC();
    }
}

typedef _Float16 h16x2 __attribute__((ext_vector_type(2)));
#define U8H_LO(w) __builtin_bit_cast(h16x2, __builtin_amdgcn_perm(0x64646464u, (unsigned)(w), 0x04010400u))
#define U8H_HI(w) __builtin_bit_cast(h16x2, __builtin_amdgcn_perm(0x64646464u, (unsigned)(w), 0x04030402u))
__device__ __forceinline__ float dot16_fp8(const u32x4 r, const h16x2* x) {
    float a = __builtin_amdgcn_fdot2(U8H_LO(r.x), x[0], 0.f, false); a = __builtin_amdgcn_fdot2(U8H_HI(r.x), x[1], a, false);
    a = __builtin_amdgcn_fdot2(U8H_LO(r.y), x[2], a, false); a = __builtin_amdgcn_fdot2(U8H_HI(r.y), x[3], a, false);
    a = __builtin_amdgcn_fdot2(U8H_LO(r.z), x[4], a, false); a = __builtin_amdgcn_fdot2(U8H_HI(r.z), x[5], a, false);
    a = __builtin_amdgcn_fdot2(U8H_LO(r.w), x[6], a, false); a = __builtin_amdgcn_fdot2(U8H_HI(r.w), x[7], a, false);
    return a;
}
__device__ __forceinline__ void axpy16_fp8(const u32x4 r, const h16x2 cf, h16x2* y) {
    const h16x2 off = (h16x2){(_Float16)(-1152.0f), (_Float16)(-1152.0f)};
    y[0] += (U8H_LO(r.x) + off) * cf; y[1] += (U8H_HI(r.x) + off) * cf; y[2] += (U8H_LO(r.y) + off) * cf; y[3] += (U8H_HI(r.y) + off) * cf;
    y[4] += (U8H_LO(r.z) + off) * cf; y[5] += (U8H_HI(r.z) + off) * cf; y[6] += (U8H_LO(r.w) + off) * cf; y[7] += (U8H_HI(r.w) + off) * cf;
}
template <int B0> __device__ __forceinline__ void treduce16(const float (&v)[16], const int lane, float& out0, float& out1) {
    const bool s0 = lane & B0, s1 = lane & (2 * B0), s2 = lane & (4 * B0);
    float w[8], x[4];
#pragma unroll
    for (int k = 0; k < 8; ++k) { const float keep = s0 ? v[2 * k + 1] : v[2 * k], give = s0 ? v[2 * k] : v[2 * k + 1]; w[k] = keep + __shfl_xor(give, B0); }
#pragma unroll
    for (int k = 0; k < 4; ++k) { const float keep = s1 ? w[2 * k + 1] : w[2 * k], give = s1 ? w[2 * k] : w[2 * k + 1]; x[k] = keep + __shfl_xor(give, 2 * B0); }
    { const float keep = s2 ? x[1] : x[0], give = s2 ? x[0] : x[1]; out0 = keep + __shfl_xor(give, 4 * B0); }
    { const float keep = s2 ? x[3] : x[2], give = s2 ? x[2] : x[3]; out1 = keep + __shfl_xor(give, 4 * B0); }
}
struct PeerMap { int xcd, wv, nwv; };
__device__ __forceinline__ PeerMap peer_map() { PeerMap m; m.xcd = blockIdx.x & 7; m.wv = (blockIdx.x >> 3) * 8 + (threadIdx.x >> 6); m.nwv = (((int)gridDim.x - m.xcd + 7) >> 3) * 8; return m; }

__device__ __forceinline__ void peer_xquant(const Params& p, int layer, const SSRef ssin, const bf16_t* HBin) {
    const int lane = threadIdx.x & 63, gw = blockIdx.x * 8 + (threadIdx.x >> 6), NGW = gridDim.x * 8;
    const float* cn = p.in[13] + layer * D;
    unsigned* XQ = (unsigned*)(p.ws + WS_XQ); float* XS = (float*)(p.ws + WS_XS);
    for (int t = gw; t < T; t += NGW) {
        const float rs = rstd_of(ss_get(ssin, t));
        f32x4 x[8];
#pragma unroll
        for (int k = 0; k < 8; ++k) { const u32x2 hb = *(const u32x2*)(HBin + (size_t)t * D + k * 256 + lane * 4); x[k] = (f32x4){bflo(hb.x), bfhi(hb.x), bflo(hb.y), bfhi(hb.y)} * rs * *(const f32x4*)(cn + k * 256 + lane * 4); }
#pragma unroll
        for (int k = 0; k < 8; ++k) {
            float am = fmaxf(fmaxf(fabsf(x[k][0]), fabsf(x[k][1])), fmaxf(fabsf(x[k][2]), fabsf(x[k][3])));
            am = fmaxf(am, __shfl_xor(am, 1)); am = fmaxf(am, __shfl_xor(am, 2));
            const float sc = am > 0.f ? 127.0f / am : 0.f;
            const unsigned q0 = (unsigned)(int)rintf(x[k][0] * sc) & 255u, q1 = (unsigned)(int)rintf(x[k][1] * sc) & 255u, q2 = (unsigned)(int)rintf(x[k][2] * sc) & 255u, q3 = (unsigned)(int)rintf(x[k][3] * sc) & 255u;
            XQ[(size_t)t * 512 + k * 64 + lane] = q0 | (q1 << 8) | (q2 << 16) | (q3 << 24);
            if ((lane & 3) == 0) XS[(size_t)t * 128 + k * 16 + (lane >> 2)] = am * (1.0f / 127.0f);
        }
    }
}
__device__ __forceinline__ float dot16_i8(const u32x4 r, const u32x4 x) {
    int a = __builtin_amdgcn_sdot4((int)r.x, (int)x.x, 0, false); a = __builtin_amdgcn_sdot4((int)r.y, (int)x.y, a, false);
    a = __builtin_amdgcn_sdot4((int)r.z, (int)x.z, a, false); a = __builtin_amdgcn_sdot4((int)r.w, (int)x.w, a, false);
    return (float)a;
}
__device__ __forceinline__ void peer_upass(const Params& p, int layer) {
    const int lane = threadIdx.x & 63, q = lane >> 3, c = lane & 7; const PeerMap pm = peer_map();
    const int* EIDX = (const int*)(p.ws + WS_EIDX); _Float16* PA = (_Float16*)(p.ws + WS_PA);
    const unsigned char* XQ = p.ws + WS_XQ; const float* XS = (const float*)(p.ws + WS_XS);
    for (int r = 0; r < 2; ++r) {
        const int sl = pm.xcd + 8 * r;
        const unsigned char* U8 = p.ws + WS_UB + (size_t)(layer * 16 + sl) * 16384 * 128; const unsigned c16 = c * 16;
        int idx[16], idxn[16]; u32x4 rowsA[8], rowsB[8]; u32x4 xq = (u32x4){0u, 0u, 0u, 0u}, xqn = xq; float xs = 0.f, xsn = 0.f;
        if (pm.wv < T) {
#pragma unroll
            for (int i = 0; i < 4; ++i) { const int4 e4 = *(const int4*)(EIDX + (size_t)pm.wv * 128 + q * 16 + 4 * i); idx[4 * i] = e4.x; idx[4 * i + 1] = e4.y; idx[4 * i + 2] = e4.z; idx[4 * i + 3] = e4.w; }
            xq = *(const u32x4*)(XQ + (size_t)pm.wv * D + sl * 128 + c16); xs = XS[(size_t)pm.wv * 128 + sl * 8 + c];
#pragma unroll
            for (int i = 0; i < 8; ++i) rowsA[i] = *(const u32x4*)(U8 + (((unsigned)idx[i] << 7) | c16));
        }
        for (int t = pm.wv; t < T; t += pm.nwv) {
#pragma unroll
            for (int i = 0; i < 8; ++i) rowsB[i] = *(const u32x4*)(U8 + (((unsigned)idx[8 + i] << 7) | c16));
            const int tn = t + pm.nwv; const bool nv = tn < T;
            if (nv) {
#pragma unroll
                for (int i = 0; i < 4; ++i) { const int4 e4 = *(const int4*)(EIDX + (size_t)tn * 128 + q * 16 + 4 * i); idxn[4 * i] = e4.x; idxn[4 * i + 1] = e4.y; idxn[4 * i + 2] = e4.z; idxn[4 * i + 3] = e4.w; }
                xqn = *(const u32x4*)(XQ + (size_t)tn * D + sl * 128 + c16); xsn = XS[(size_t)tn * 128 + sl * 8 + c];
            }
            float v[16];
#pragma unroll
            for (int i = 0; i < 8; ++i) v[i] = dot16_i8(rowsA[i], xq) * xs;
            if (nv) {
#pragma unroll
                for (int i = 0; i < 8; ++i) rowsA[i] = *(const u32x4*)(U8 + (((unsigned)idxn[i] << 7) | c16));
            }
#pragma unroll
            for (int i = 0; i < 8; ++i) v[8 + i] = dot16_i8(rowsB[i], xq) * xs;
            float z0, z1; treduce16<1>(v, lane, z0, z1);
            _Float16* pa = PA + ((size_t)t * 16 + sl) * 128 + 8 * c + q;
            pa[0] = (_Float16)z0; pa[64] = (_Float16)z1;
#pragma unroll
            for (int i = 0; i < 16; ++i) idx[i] = idxn[i];
            xq = xqn; xs = xsn;
        }
    }
}
__device__ __forceinline__ void peer_combine(const Params& p, int layer) {
    const int lane = threadIdx.x & 63, gw = blockIdx.x * 8 + (threadIdx.x >> 6), NGW = gridDim.x * 8;
    const int* EIDX = (const int*)(p.ws + WS_EIDX); const float* GW = (const float*)(p.ws + WS_GW); const _Float16* PA = (const _Float16*)(p.ws + WS_PA);
    const float* USC = (const float*)(p.ws + WS_USC) + layer * 16384; const float* VSC = (const float*)(p.ws + WS_VSC) + layer * 16384;
    int2* CI = (int2*)(p.ws + WS_CI);
    for (int t = gw; t < T; t += NGW) {
        float a_lo = 0.f, a_hi = 0.f;
#pragma unroll
        for (int s2 = 0; s2 < 16; ++s2) { a_lo += (float)PA[((size_t)t * 16 + s2) * 128 + lane]; a_hi += (float)PA[((size_t)t * 16 + s2) * 128 + 64 + lane]; }
        const int e_lo = EIDX[(size_t)t * 128 + (lane & 7) * 16 + (lane >> 3)], e_hi = EIDX[(size_t)t * 128 + (lane & 7) * 16 + 8 + (lane >> 3)];
        a_lo *= USC[e_lo]; a_hi *= USC[e_hi];
        const float c_lo = GW[(size_t)t * 128 + lane] * 0.5f * a_lo * (1.0f + erff(a_lo * 0.70710678118f)) * VSC[e_lo];
        const float c_hi = GW[(size_t)t * 128 + 64 + lane] * 0.5f * a_hi * (1.0f + erff(a_hi * 0.70710678118f)) * VSC[e_hi];
        float mx = fmaxf(fabsf(c_lo), fabsf(c_hi));
#pragma unroll
        for (int o = 1; o < 64; o <<= 1) mx = fmaxf(mx, __shfl_xor(mx, o));
        const float qs = mx > 0.f ? 127.0f / mx : 0.f, tsc = mx * (1.0f / 127.0f);
        const int kb = 8 * ((lane >> 3) & 3);
        unsigned w_lo = ((unsigned)(int)rintf(c_lo * qs) & 255u) << kb, w_hi = ((unsigned)(int)rintf(c_hi * qs) & 255u) << kb;
        w_lo |= __shfl_xor(w_lo, 8); w_lo |= __shfl_xor(w_lo, 16); w_hi |= __shfl_xor(w_hi, 8); w_hi |= __shfl_xor(w_hi, 16);
        if (((lane >> 3) & 3) == 0) { unsigned* CFQ = (unsigned*)CI; CFQ[(size_t)t * 32 + (lane >> 5) * 8 + (lane & 7)] = w_lo; CFQ[(size_t)t * 32 + (2 + (lane >> 5)) * 8 + (lane & 7)] = w_hi; }
        if (lane == 0) ((float*)(p.ws + WS_SS) + 6 * T)[t] = tsc;
    }
}
__device__ __forceinline__ void vgrp4(const unsigned a, const unsigned b, const unsigned c, const unsigned d, const int cw, int* acc) {
    const unsigned ab_lo = __builtin_amdgcn_perm(b, a, 0x05010400u), ab_hi = __builtin_amdgcn_perm(b, a, 0x07030602u);
    const unsigned cd_lo = __builtin_amdgcn_perm(d, c, 0x05010400u), cd_hi = __builtin_amdgcn_perm(d, c, 0x07030602u);
    acc[0] = __builtin_amdgcn_sdot4((int)__builtin_amdgcn_perm(cd_lo, ab_lo, 0x05040100u), cw, acc[0], false);
    acc[1] = __builtin_amdgcn_sdot4((int)__builtin_amdgcn_perm(cd_lo, ab_lo, 0x07060302u), cw, acc[1], false);
    acc[2] = __builtin_amdgcn_sdot4((int)__builtin_amdgcn_perm(cd_hi, ab_hi, 0x05040100u), cw, acc[2], false);
    acc[3] = __builtin_amdgcn_sdot4((int)__builtin_amdgcn_perm(cd_hi, ab_hi, 0x07060302u), cw, acc[3], false);
}
__device__ __forceinline__ void vrows4(const u32x4 a, const u32x4 b, const u32x4 c, const u32x4 d, const int cw, int* acc) {
    vgrp4(a.x, b.x, c.x, d.x, cw, acc); vgrp4(a.y, b.y, c.y, d.y, cw, acc + 4); vgrp4(a.z, b.z, c.z, d.z, cw, acc + 8); vgrp4(a.w, b.w, c.w, d.w, cw, acc + 12);
}
__device__ __forceinline__ void peer_vpass(const Params& p, int layer, float* SSQ, const bf16_t* HBin, bf16_t* HBout) {
    const int lane = threadIdx.x & 63, q = lane >> 3, c = lane & 7; const PeerMap pm = peer_map();
    const int* EIDX = (const int*)(p.ws + WS_EIDX); const int* CFQ = (const int*)(p.ws + WS_CI); const float* TSC = (const float*)(p.ws + WS_SS) + 6 * T;
    for (int r = 0; r < 2; ++r) {
        const int sl = pm.xcd + 8 * r;
        const unsigned char* V8 = p.ws + WS_VB + (size_t)(layer * 16 + sl) * 16384 * 128; const unsigned c16 = c * 16;
        int idx[16], idxn[16], cw[4], cwn[4]; u32x4 rowsA[8], rowsB[8];
        if (pm.wv < T) {
#pragma unroll
            for (int i = 0; i < 4; ++i) { const int4 e4 = *(const int4*)(EIDX + (size_t)pm.wv * 128 + q * 16 + 4 * i); idx[4 * i] = e4.x; idx[4 * i + 1] = e4.y; idx[4 * i + 2] = e4.z; idx[4 * i + 3] = e4.w; }
#pragma unroll
            for (int j = 0; j < 4; ++j) cw[j] = CFQ[(size_t)pm.wv * 32 + j * 8 + q];
#pragma unroll
            for (int i = 0; i < 8; ++i) rowsA[i] = *(const u32x4*)(V8 + (((unsigned)idx[i] << 7) | c16));
        }
        for (int t = pm.wv; t < T; t += pm.nwv) {
#pragma unroll
            for (int i = 0; i < 8; ++i) rowsB[i] = *(const u32x4*)(V8 + (((unsigned)idx[8 + i] << 7) | c16));
            const size_t off = (size_t)t * D + sl * 128 + c * 16 + q;
            const float h0 = __uint_as_float((unsigned)HBin[off] << 16), h1 = __uint_as_float((unsigned)HBin[off + 8] << 16), tsc = TSC[t];
            const int tn = t + pm.nwv; const bool nv = tn < T;
            if (nv) {
#pragma unroll
                for (int i = 0; i < 4; ++i) { const int4 e4 = *(const int4*)(EIDX + (size_t)tn * 128 + q * 16 + 4 * i); idxn[4 * i] = e4.x; idxn[4 * i + 1] = e4.y; idxn[4 * i + 2] = e4.z; idxn[4 * i + 3] = e4.w; }
#pragma unroll
                for (int j = 0; j < 4; ++j) cwn[j] = CFQ[(size_t)tn * 32 + j * 8 + q];
            }
            int acc[16];
#pragma unroll
            for (int k = 0; k < 16; ++k) acc[k] = 0;
            vrows4(rowsA[0], rowsA[1], rowsA[2], rowsA[3], cw[0], acc); vrows4(rowsA[4], rowsA[5], rowsA[6], rowsA[7], cw[1], acc);
            if (nv) {
#pragma unroll
                for (int i = 0; i < 8; ++i) rowsA[i] = *(const u32x4*)(V8 + (((unsigned)idxn[i] << 7) | c16));
            }
            vrows4(rowsB[0], rowsB[1], rowsB[2], rowsB[3], cw[2], acc); vrows4(rowsB[4], rowsB[5], rowsB[6], rowsB[7], cw[3], acc);
            float v[16];
#pragma unroll
            for (int k = 0; k < 16; ++k) v[k] = (float)acc[k];
            float z0, z1; treduce16<8>(v, lane, z0, z1);
            const float o0 = h0 + z0 * tsc, o1 = h1 + z1 * tsc;
            HBout[off] = (bf16_t)(pk2(o0, 0.f) & 0xffffu); HBout[off + 8] = (bf16_t)(pk2(o1, 0.f) & 0xffffu);
            const float ss = wave_sum(o0 * o0 + o1 * o1);
            if (lane == 0) SSQ[(size_t)t * 16 + sl] = ss;
#pragma unroll
            for (int i = 0; i < 16; ++i) idx[i] = idxn[i];
#pragma unroll
            for (int j = 0; j < 4; ++j) cw[j] = cwn[j];
        }
    }
}

__device__ __forceinline__ void swa_phase(const Params& p, LAS unsigned char* lds) {
    const int tid = threadIdx.x, lane = tid & 63, w = tid >> 6, fr = lane & 15, g = lane >> 4;
    const bf16_t* QK2 = (const bf16_t*)(p.ws + WS_QK2); const bf16_t* VT2 = (const bf16_t*)(p.ws + WS_VT2); bf16_t* O = (bf16_t*)(p.ws + WS_O);
    LAS unsigned char* Ks = lds; LAS unsigned char* VTs = lds + 27648;
    u32x4 pk[3], pv[3];
#define SWA_ISSUE(it_) do { const int i_ = (it_); const int t0_ = (i_ & 127) * 64, kvh_ = (i_ >> 7) & 3, b_ = i_ >> 9; \
        _Pragma("unroll") for (int j = 0; j < 3; ++j) { const int q = tid + 512 * j; \
            { const int row = q >> 3, cc = q & 7; int tk = t0_ - 128 + row; tk = tk < 0 ? 0 : tk; pk[j] = *(const u32x4*)(QK2 + ((size_t)b_ * SEQ + tk) * 2304 + 2048 + kvh_ * 64 + cc * 8); } \
            { const int d = q / 24, cc = q % 24; const int tk = t0_ - 128 + cc * 8; pv[j] = (u32x4){0u, 0u, 0u, 0u}; if (tk >= 0) pv[j] = *(const u32x4*)(VT2 + (size_t)(kvh_ * 64 + d) * T + (size_t)b_ * SEQ + tk); } } } while (0)
    if ((int)blockIdx.x < 1024) SWA_ISSUE(blockIdx.x);
    for (int item = blockIdx.x; item < 1024; item += gridDim.x) {
        const int t0 = (item & 127) * 64, kvh = (item >> 7) & 3, b = item >> 9;
#pragma unroll
        for (int j = 0; j < 3; ++j) { const int q = tid + 512 * j; *(LAS u32x4*)(Ks + (q >> 3) * 144 + (q & 7) * 16) = pk[j]; *(LAS u32x4*)(VTs + (q / 24) * 400 + (q % 24) * 16) = pv[j]; }
        if (item + (int)gridDim.x < 1024) SWA_ISSUE(item + (int)gridDim.x);
        asm volatile("s_waitcnt lgkmcnt(0)" ::: "memory"); __builtin_amdgcn_s_barrier(); asm volatile("" ::: "memory");
        const int qh = kvh * 8 + w; const float sink = p.in[11][qh];
        for (int u = 0; u < 2; ++u) {
            const int t0u = t0 + 32 * u; const LAS unsigned char* Ku = Ks + 32 * u * 144; const LAS unsigned char* Vu = VTs + 64 * u;
            bf16x8 bq[2][2];
#pragma unroll
            for (int tt = 0; tt < 2; ++tt)
#pragma unroll
                for (int ks = 0; ks < 2; ++ks) bq[tt][ks] = *(const bf16x8*)(QK2 + ((size_t)b * SEQ + t0u + tt * 16 + fr) * 2304 + qh * 64 + ks * 32 + g * 8);
            f32x4 s[10][2];
#pragma unroll
            for (int kt = 0; kt < 10; ++kt) {
                s[kt][0] = (f32x4){0.f, 0.f, 0.f, 0.f}; s[kt][1] = (f32x4){0.f, 0.f, 0.f, 0.f};
#pragma unroll
                for (int ks = 0; ks < 2; ++ks) { const bf16x8 a = lfrag(Ku, kt * 16 + fr, 144, ks * 64 + g * 16);
                    s[kt][0] = mfma16(a, bq[0][ks], s[kt][0]); s[kt][1] = mfma16(a, bq[1][ks], s[kt][1]); }
            }
            float den[2];
#pragma unroll
            for (int tt = 0; tt < 2; ++tt) { const int t = tt * 16 + fr; float mx = sink;
#pragma unroll
                for (int kt = 0; kt < 10; ++kt)
#pragma unroll
                    for (int i = 0; i < 4; ++i) { const int kk = kt * 16 + g * 4 + i; const bool valid = (kk > t) && (kk <= t + 128) && (t0u - 128 + kk >= 0);
                        s[kt][tt][i] = valid ? s[kt][tt][i] : -INFINITY; mx = fmaxf(mx, s[kt][tt][i]); }
                mx = fmaxf(mx, __shfl_xor(mx, 16)); mx = fmaxf(mx, __shfl_xor(mx, 32));
                float sum = 0.f;
#pragma unroll
                for (int kt = 0; kt < 10; ++kt)
#pragma unroll
                    for (int i = 0; i < 4; ++i) { const float pr = __expf(s[kt][tt][i] - mx); s[kt][tt][i] = pr; sum += pr; }
                sum += __shfl_xor(sum, 16); sum += __shfl_xor(sum, 32);
                den[tt] = sum + __expf(sink - mx); }
            f32x4 o[4][2];
#pragma unroll
            for (int dt = 0; dt < 4; ++dt) { o[dt][0] = (f32x4){0.f, 0.f, 0.f, 0.f}; o[dt][1] = (f32x4){0.f, 0.f, 0.f, 0.f}; }
#pragma unroll
            for (int sx = 0; sx < 5; ++sx) {
                bf16x8 bp[2];
#pragma unroll
                for (int tt = 0; tt < 2; ++tt) { const u32x4 pkd = (u32x4){pk2(s[2 * sx][tt][0], s[2 * sx][tt][1]), pk2(s[2 * sx][tt][2], s[2 * sx][tt][3]), pk2(s[2 * sx + 1][tt][0], s[2 * sx + 1][tt][1]), pk2(s[2 * sx + 1][tt][2], s[2 * sx + 1][tt][3])};
                    bp[tt] = __builtin_bit_cast(bf16x8, pkd); }
#pragma unroll
                for (int dt = 0; dt < 4; ++dt) {
                    const u32x2 lo = *(const LAS u32x2*)(Vu + (dt * 16 + fr) * 400 + ((2 * sx) * 16 + g * 4) * 2), hi = *(const LAS u32x2*)(Vu + (dt * 16 + fr) * 400 + ((2 * sx + 1) * 16 + g * 4) * 2);
                    const bf16x8 a = __builtin_bit_cast(bf16x8, (u32x4){lo.x, lo.y, hi.x, hi.y});
                    o[dt][0] = mfma16(a, bp[0], o[dt][0]); o[dt][1] = mfma16(a, bp[1], o[dt][1]);
                }
            }
#pragma unroll
            for (int tt = 0; tt < 2; ++tt) { const float inv = 1.0f / den[tt];
#pragma unroll
                for (int dt = 0; dt < 4; ++dt)
                    *(u32x2*)(O + ((size_t)b * SEQ + t0u + tt * 16 + fr) * 2048 + qh * 64 + dt * 16 + g * 4) = (u32x2){pk2(o[dt][tt][0] * inv, o[dt][tt][1] * inv), pk2(o[dt][tt][2] * inv, o[dt][tt][3] * inv)}; }
        }
        asm volatile("s_waitcnt lgkmcnt(0)" ::: "memory"); __builtin_amdgcn_s_barrier(); asm volatile("" ::: "memory");
    }
#undef SWA_ISSUE
}

__device__ __forceinline__ void final_phase(const Params& p, const bf16_t* HBin) {
    const int lane = threadIdx.x & 63, gw = blockIdx.x * 8 + (threadIdx.x >> 6), NGW = gridDim.x * 8;
    const SSRef ss{(const float*)(p.ws + WS_SSP) + (size_t)3 * T * 32, 32}; const float* fn = p.in[22];
    for (int m = gw; m < T; m += NGW) { const float rs = rstd_of(ss_get(ss, m));
#pragma unroll
        for (int j = 0; j < 4; ++j) { const size_t off = (size_t)m * D + j * 512 + lane * 8; const u32x4 hb = *(const u32x4*)(HBin + off);
            const f32x4 n0 = *(const f32x4*)(fn + j * 512 + lane * 8), n1 = *(const f32x4*)(fn + j * 512 + lane * 8 + 4);
            *(f32x4*)(p.out + off) = (f32x4){bflo(hb.x), bfhi(hb.x), bflo(hb.y), bfhi(hb.y)} * rs * n0;
            *(f32x4*)(p.out + off + 4) = (f32x4){bflo(hb.z), bfhi(hb.z), bflo(hb.w), bfhi(hb.w)} * rs * n1; } }
}

#define RLX_AGENT __ATOMIC_RELAXED, __HIP_MEMORY_SCOPE_AGENT
#define XB_TMO      128
#define XB_XCNT(j)  (256  + 64 * (j))
#define XB_XSUB(j)  (1280 + 64 * (j))
#define XB_XGEN(j)  (2304 + 64 * (j))
#define XB_TOP      3328
#define XB_TOPGEN   3392
#define XCD_BAR_WORDS 3456
#define XB_SPIN_CAP (1u << 18)

__device__ __forceinline__ unsigned xb_ld(unsigned* p)              { return __hip_atomic_load(p, __ATOMIC_RELAXED, __HIP_MEMORY_SCOPE_AGENT); }
__device__ __forceinline__ unsigned xb_add(unsigned* p, unsigned v) { return __hip_atomic_fetch_add(p, v, __ATOMIC_RELAXED, __HIP_MEMORY_SCOPE_AGENT); }
__device__ __forceinline__ unsigned xb_xcc_id() { return (unsigned)__builtin_amdgcn_s_getreg((3 << 11) | 20) & 0xFu; }
#define XB_SPIN(cond, bar) do { unsigned _sp = 0; while (cond) { __builtin_amdgcn_s_sleep(1); \
    if ((++_sp & 255u) == 0u) { if (xb_ld(&(bar)[XB_TMO])) break; if (_sp > XB_SPIN_CAP) { atomicAdd(&(bar)[XB_TMO], 1u); break; } } } } while (0)

struct XcdBarrier {
    unsigned* bar; unsigned x;
    volatile LAS unsigned* st;
};

__device__ __forceinline__ XcdBarrier xcd_barrier_post(unsigned* bar, volatile LAS unsigned* st) {
    XcdBarrier b; b.bar = bar; b.x = xb_xcc_id(); b.st = st;
    if (threadIdx.x == 0) (void)xb_add(&bar[XB_XCNT(b.x)], 1u);
    return b;
}
__device__ __forceinline__ void xcd_barrier_complete(unsigned* bar, unsigned x, unsigned& nloc, unsigned& nx) {
    const unsigned G = gridDim.x * gridDim.y * gridDim.z;
    unsigned sum, cnt, mine, sp = 0u;
    for (;;) {
        sum = 0u; cnt = 0u; mine = 0u;
#pragma unroll
        for (unsigned j = 0; j < 16; ++j) { const unsigned c = xb_ld(&bar[XB_XCNT(j)]); sum += c; cnt += (c > 0u) ? 1u : 0u; mine = (j == x) ? c : mine; }
        if (sum == G) break;
        __builtin_amdgcn_s_sleep(1);
        if ((++sp & 255u) == 0u) { if (xb_ld(&bar[XB_TMO])) break; if (sp > XB_SPIN_CAP) { atomicAdd(&bar[XB_TMO], 1u); break; } }
    }
    nloc = mine > 0u ? mine : 1u; nx = cnt > 0u ? cnt : 1u;
}

__device__ __forceinline__ void xcd_barrier(const XcdBarrier& b) {
    asm volatile("s_waitcnt vmcnt(0)" ::: "memory");
    __syncthreads();
    if (threadIdx.x == 0) {
        unsigned* bar = b.bar;
        __builtin_amdgcn_s_waitcnt(0);
        unsigned nloc = b.st[0], nx = b.st[1];
        if (nloc == 0u) { xcd_barrier_complete(bar, b.x, nloc, nx); b.st[0] = nloc; b.st[1] = nx; }
        const unsigned old = xb_add(&bar[XB_XSUB(b.x)], 1u);
        const unsigned gen = old / nloc;
        if (old + 1u == (gen + 1u) * nloc) {
            __builtin_amdgcn_fence(__ATOMIC_RELEASE, "agent");
            asm volatile("s_waitcnt vmcnt(0)" ::: "memory");
            const unsigned og = xb_add(&bar[XB_TOP], 1u);
            const unsigned tg = og / nx;
            if (og + 1u == (tg + 1u) * nx) xb_add(&bar[XB_TOPGEN], 1u);
            else XB_SPIN(xb_ld(&bar[XB_TOPGEN]) == tg, bar);
            __builtin_amdgcn_fence(__ATOMIC_ACQUIRE, "agent");
            xb_add(&bar[XB_XGEN(b.x)], 1u);
            asm volatile("s_waitcnt vmcnt(0)" ::: "memory");
        } else {
            XB_SPIN(xb_ld(&bar[XB_XGEN(b.x)]) == gen, bar);
            __builtin_amdgcn_fence(__ATOMIC_ACQUIRE, "agent");
            asm volatile("s_waitcnt vmcnt(0)" ::: "memory");
        }
    }
    __syncthreads();
}
__global__ void __launch_bounds__(512, 2) yoco_fwd(Params p) {
    extern __shared__ __attribute__((aligned(16))) unsigned char lds_raw[];
    LAS unsigned char* lds = (LAS unsigned char*)lds_raw;
    cg::grid_group grid = cg::this_grid();
    volatile LAS unsigned* bst = (volatile LAS unsigned*)(lds + (LDS_BYTES - 16));
    if (threadIdx.x < 4) bst[threadIdx.x] = 0u;
    __syncthreads();
    const XcdBarrier xbar = xcd_barrier_post((unsigned*)(p.ws + WS_BAR), bst);
    unsigned char* ws = p.ws;
    float* SS = (float*)(ws + WS_SS);
    bf16_t* HBA = (bf16_t*)(ws + WS_HBA); bf16_t* HBB = (bf16_t*)(ws + WS_HBB);
    const int lo = p.ph_lo, hi = p.ph_hi;
#define IN(k) (lo <= (k) && (k) < hi)
#define SEAM(k) do { if (IN(k) && IN((k) + 1)) xcd_barrier(xbar); } while (0)
    float* SSP = (float*)(ws + WS_SSP);
    float* SSQ = (float*)(ws + WS_SSQ);
    const SSRef ss0{SS, 1}, ss2{SSQ, 16}, ss5{SSQ + (size_t)T * 16, 16}, ssN{nullptr, 1};
    const SSRef ss1{SSP, 32}, ss3{SSP + (size_t)1 * T * 32, 32}, ss4{SSP + (size_t)2 * T * 32, 32};
    if (p.ph_hi < 0) grid.sync();
    if (IN(0)) p0_prologue(p, lds);
    SEAM(0);
    if (IN(1)) {
        if (blockIdx.x < 8) gate_prefix(p, lds, blockIdx.x);
        { EpiScale E{(bf16_t*)(ws + WS_QK), 2048, ss0, ssN}; run_gemm(lds, HBA, (const bf16_t*)(ws + WS_WIN), T, 2048, 2048, E); }
        { EpiScale E{(bf16_t*)(ws + WS_OG), 2048, ss0, ssN}; run_gemm(lds, HBA, (const bf16_t*)(ws + WS_WIN) + (size_t)4096 * 2048, T, 2048, 2048, E); }
        { EpiScale E{(bf16_t*)(ws + WS_KVT), T, ssN, ss0}; run_gemm(lds, (const bf16_t*)(ws + WS_WIN) + (size_t)2048 * 2048, HBA, 2048, T, 2048, E); }
        { EpiScale E{(bf16_t*)(ws + WS_PP), 2048, ssN, ssN}; run_gemm(lds, (const bf16_t*)(ws + WS_PB), (const bf16_t*)(ws + WS_WPR), T, 2048, 256, E); }
    }
    SEAM(1);
    if (IN(2)) { if (NSEG > 1) for (int it = blockIdx.x; it < 8 * 8 * (NSEG - 1); it += gridDim.x) mlstm_item(p, lds, it & 7, (it >> 3) & 7, it >> 6, false);
        if (gridDim.x == 256 && blockIdx.x >= 192)
            cvt_rows_fp8(p.in[17], ws + WS_UB, (float*)(ws + WS_USC), 16384, 2 * 16384, ((int)blockIdx.x - 192) * 8 + (int)(threadIdx.x >> 6), 64 * 8, (int)(threadIdx.x & 63), 0); }
    SEAM(2);
    if (IN(3)) { for (int it = blockIdx.x; it < 8 * 8 * NSEG; it += gridDim.x) mlstm_item(p, lds, it & 7, (it >> 3) & 7, it >> 6, true); }
    SEAM(3);
    if (IN(4)) headnorm_phase(p);
    SEAM(4);
    if (IN(5)) { EpiRes<false, true> E{p.in[0], HBB, SSP, nullptr, ssN}; run_gemm(lds, (const bf16_t*)(ws + WS_QK), (const bf16_t*)(ws + WS_WOUT), T, 2048, 2048, E); }
    SEAM(5);
    if (IN(6)) { EpiScale E{(bf16_t*)(ws + WS_QK), 2048, ss1, ssN}; run_gemm(lds, HBB, (const bf16_t*)(ws + WS_WPQ), T, 2048, 2048, E); }
    SEAM(6);
    if (IN(7)) { peer_topk(p, lds, 0, ss1); peer_xquant(p, 0, ss1, HBB); }
    SEAM(7);
    if (IN(8)) { peer_upass(p, 0); xcd_barrier(xbar); peer_combine(p, 0); xcd_barrier(xbar); peer_vpass(p, 0, SSQ, HBB, HBA); }
    SEAM(8);
    if (IN(9)) { EpiRes<true, false> E{HBA, HBB, SSP + (size_t)1 * T * 32, (const bf16_t*)(ws + WS_PP), ss2}; run_gemm(lds, HBA, (const bf16_t*)(ws + WS_WG), T, 2048, 2048, E); }
    SEAM(9);
    if (IN(10)) {
        { EpiScale E{(bf16_t*)(ws + WS_QK2), 2304, ss3, ssN}; run_gemm(lds, HBB, (const bf16_t*)(ws + WS_WQKV), T, 2304, 2048, E); }
        { EpiScale E{(bf16_t*)(ws + WS_VT2), T, ssN, ss3}; run_gemm(lds, (const bf16_t*)(ws + WS_WQKV) + (size_t)2304 * 2048, HBB, 256, T, 2048, E, 576); }
        { EpiScale E{(bf16_t*)(ws + WS_PP), 2048, ssN, ssN}; run_gemm(lds, (const bf16_t*)(ws + WS_PB) + (size_t)T * 256, (const bf16_t*)(ws + WS_WPR) + (size_t)D * 256, T, 2048, 256, E, 576 + 64); }
        if (gridDim.x == 256 && blockIdx.x >= 128)
        {   cvt_rows_fp8(p.in[18], ws + WS_VB, (float*)(ws + WS_VSC), 16384, 2 * 16384, ((int)blockIdx.x - 128) * 8 + (int)(threadIdx.x >> 6), 128 * 8, (int)(threadIdx.x & 63), 0);
            const int wave2 = (int)(threadIdx.x >> 6), lane2 = (int)(threadIdx.x & 63); LAS float* scr = (LAS float*)(lds + wave2 * 16640);
            for (int it = ((int)blockIdx.x - 128) * 8 + wave2; it < 3 * 32 * 32; it += 128 * 8) { int r = it;
                if (tr_job(r, p.in[12], 2048, 2048, 0, 2048, (bf16_t*)(ws + WS_WO), nullptr, 0, 1.f, scr, lane2)) continue;
                if (tr_job(r, p.in[14] + (size_t)D * D, 2048, 2048, 0, 2048, (bf16_t*)(ws + WS_WPQ) + (size_t)D * D, p.in[13] + D, 0, 1.f, scr, lane2)) continue;
                tr_job(r, p.in[20] + (size_t)D * D, 2048, 2048, 0, 2048, (bf16_t*)(ws + WS_WG) + (size_t)D * D, p.in[19] + D, 0, 1.f, scr, lane2); } }
    }
    SEAM(10);
    if (IN(11)) swa_phase(p, lds);
    SEAM(11);
    if (IN(12)) { EpiRes<false, false> E{HBB, HBA, SSP + (size_t)2 * T * 32, nullptr, ssN}; run_gemm(lds, (const bf16_t*)(ws + WS_O), (const bf16_t*)(ws + WS_WO), T, 2048, 2048, E); }
    SEAM(12);
    if (IN(13)) { EpiScale E{(bf16_t*)(ws + WS_QK), 2048, ss4, ssN}; run_gemm(lds, HBA, (const bf16_t*)(ws + WS_WPQ) + (size_t)D * D, T, 2048, 2048, E); }
    SEAM(13);
    if (IN(14)) { peer_topk(p, lds, 1, ss4); peer_xquant(p, 1, ss4, HBA); }
    SEAM(14);
    if (IN(15)) { peer_upass(p, 1); xcd_barrier(xbar); peer_combine(p, 1); xcd_barrier(xbar); peer_vpass(p, 1, SSQ + (size_t)T * 16, HBA, HBB); }
    SEAM(15);
    if (IN(16)) { EpiRes<true, false> E{HBB, HBA, SSP + (size_t)3 * T * 32, (const bf16_t*)(ws + WS_PP), ss5}; run_gemm(lds, HBB, (const bf16_t*)(ws + WS_WG) + (size_t)D * D, T, 2048, 2048, E); }
    SEAM(16);
    if (IN(17)) final_phase(p, HBA);
#undef IN
#undef SEAM
}

constexpr int N_PHASES = 18;
extern "C" void kernel_launch(void* const* d_in, const int* in_sizes, int n_in, void* d_out, int out_size, void* d_ws, size_t ws_size, hipStream_t stream) {
    static int grid = 0;
    if (grid == 0) {
        if (n_in != 23 || out_size != T * D || ws_size < WS_END) { fprintf(stderr, "kernel_launch: unexpected shapes (n_in %d out %d ws %zu need %zu)\n", n_in, out_size, ws_size, (size_t)WS_END); grid = -1; return; }
        int dev = 0, cus = 0, per_cu = 0;
        (void)hipGetDevice(&dev); (void)hipDeviceGetAttribute(&cus, hipDeviceAttributeMultiprocessorCount, dev);
        if (hipFuncSetAttribute((const void*)yoco_fwd, hipFuncAttributeMaxDynamicSharedMemorySize, LDS_BYTES) != hipSuccess) { fprintf(stderr, "kernel_launch: hipFuncSetAttribute failed\n"); grid = -1; return; }
        if (hipOccupancyMaxActiveBlocksPerMultiprocessor(&per_cu, (const void*)yoco_fwd, 512, LDS_BYTES) != hipSuccess || per_cu < 1) { fprintf(stderr, "kernel_launch: occupancy query says %d\n", per_cu); per_cu = 1; }
        (void)hipGetLastError();
        grid = cus * per_cu;
        fprintf(stderr, "kernel_launch: grid %d (cus %d x %d)\n", grid, cus, per_cu);
    }
    if (grid < 0) return;
    if (hipMemsetAsync((char*)d_ws + WS_BAR, 0, XCD_BAR_WORDS * 4, stream) != hipSuccess) { fprintf(stderr, "kernel_launch: hipMemsetAsync failed\n"); return; }
    Params p{};
    for (int i = 0; i < 23; ++i) p.in[i] = (const float*)d_in[i];
    p.out = (float*)d_out; p.ws = (unsigned char*)d_ws; p.ph_lo = 0; p.ph_hi = N_PHASES;
    void* args[] = {&p};
    hipError_t e = hipLaunchCooperativeKernel((const void*)yoco_fwd, dim3(grid), dim3(512), args, LDS_BYTES, stream);
    if (e != hipSuccess) fprintf(stderr, "kernel_launch: cooperative launch failed: %s (grid %d)\n", hipGetErrorString(e), grid);
}
```

```cpp
#include <hip/hip_runtime.h>
#include <hip/hip_cooperative_groups.h>
#include <cstdio>
#include <cstdint>
#include <cmath>
namespace cg = cooperative_groups;
namespace pg8 {
#define PG8_LAS __attribute__((address_space(3)))
typedef unsigned short bf16_t;
typedef short bf16x8 __attribute__((ext_vector_type(8)));
typedef float f32x4 __attribute__((ext_vector_type(4)));
typedef unsigned u32x4 __attribute__((ext_vector_type(4)));
constexpr int BM = 256, BK = 64, HALF = 128, HTB = HALF * BK * 2  , STAGE_BYTES = 8 * HTB, NXCD = 8, WGM = 8;

__host__ __device__ __forceinline__ int lds_byte(int r, int c) { const int st = (r >> 4) * 2 + (c >> 5), rr = r & 15, cc = c & 31, ob = rr * 64 + cc * 2; return st * 1024 + (ob ^ (((ob >> 9) & 1) << 5)); }
__host__ __device__ __forceinline__ void stage_rc(int b, int& R, int& C) { const int st = b / 1024, sb = b % 1024, swz = sb ^ (((sb >> 9) & 1) << 5); R = (st >> 1) * 16 + swz / 64; C = (st & 1) * 32 + (swz % 64) / 2; }
__host__ __device__ __forceinline__ int perm32(int rho) { const int n = rho >> 4, i = rho & 15; return 8 * (i >> 2) + 4 * n + (i & 3); }

struct Unit { int pm, pn; };
struct Gemm { const bf16_t* A; const bf16_t* Bt; int M, N, K; };

struct StaticOrder {
    int nM, nN, nwg, G, c;
    __host__ __device__ void init(int M, int N, int G_, int c_) { nM = M / BM; nN = N / BM; nwg = nM * nN; G = G_; c = c_; }
    __host__ __device__ bool next(int i, Unit& u) const {
        const long L = (long)i * G + c; if (L >= nwg) return false;
        int wgid = (int)L; { const int q = nwg / NXCD, r = nwg % NXCD, xcd = wgid % NXCD, off = wgid / NXCD; wgid = (xcd < r ? xcd * (q + 1) : r * (q + 1) + (xcd - r) * q) + off; }
        const int nig = WGM * nN, gid = wgid / nig, fm = gid * WGM, gsz = (nM - fm) < WGM ? (nM - fm) : WGM;
        u.pm = fm + ((wgid % nig) % gsz); u.pn = (wgid % nig) / gsz; return true;
    }
    __device__ __forceinline__ void a_ready(const Unit&) const {}
    __device__ __forceinline__ void done(const Unit&) const {}
};
__device__ __forceinline__ unsigned cvt_pk_bf16(float lo, float hi) { unsigned r; asm volatile("v_cvt_pk_bf16_f32 %0, %1, %2" : "=v"(r) : "v"(lo), "v"(hi)); return r; }
template <class Epi, class Sched, bool ALIGN_EPI = false, bool SP2 = false>
__device__ __forceinline__ void gemm_phase(PG8_LAS unsigned char* lds, const Gemm g, const Sched& S, const Epi& E) {
    const int tid = threadIdx.x, wid = __builtin_amdgcn_readfirstlane(tid >> 6), lane = tid & 63, wr = wid >> 2, wc = wid & 3, fr = lane & 15, fq = lane >> 4;
    const int K = g.K, nt = K / BK;
    unsigned voffA[2], voffB[2];
#pragma unroll
    for (int i = 0; i < 2; ++i) { int R, C; stage_rc(tid * 16 + i * 8192, R, C); const int Rb = Epi::PERM ? ((R & ~31) + perm32(R & 31)) : R;
        voffA[i] = (unsigned)(R * K + C) * 2u; voffB[i] = (unsigned)(Rb * K + C) * 2u; }
    const size_t kstep = (size_t)(BK * 2);
    const size_t hstep = (size_t)HALF * K * 2;
    const size_t tstep = 2 * hstep;
    const unsigned ldsw = (unsigned)wid * 1024u;
    const int aoff = lds_byte(wr * 64 + fr, fq * 8), boff = lds_byte(wc * 32 + fr, fq * 8);
#define PG8_SA(b, h) (((b) * 2 + (h)) * HTB)
#define PG8_SB(b, h) ((4 + (b) * 2 + (h)) * HTB)
#define PG8_STAGE(bufoff, gbase, voff) do { _Pragma("unroll") for (int _i = 0; _i < 2; ++_i) \
        __builtin_amdgcn_global_load_lds((const unsigned*)((const char*)(gbase) + (voff)[_i]), (PG8_LAS unsigned*)(lds + (bufoff) + ldsw + _i * 8192), 16, 0, 0); } while (0)
#define PG8_LDA(dst, b, h) do { _Pragma("unroll") for (int m = 0; m < 4; ++m) _Pragma("unroll") for (int k = 0; k < 2; ++k) dst[m][k] = *(const PG8_LAS bf16x8*)(lds + PG8_SA(b, h) + aoff + m * 2048 + k * 1024); } while (0)
#define PG8_LDB(dst, b, h) do { _Pragma("unroll") for (int n = 0; n < 2; ++n) _Pragma("unroll") for (int k = 0; k < 2; ++k) dst[n][k] = *(const PG8_LAS bf16x8*)(lds + PG8_SB(b, h) + boff + n * 2048 + k * 1024); } while (0)
#define PG8_MMA(ai, bj, At, Bt) do { __builtin_amdgcn_s_setprio(1); _Pragma("unroll") for (int m = 0; m < 4; ++m) _Pragma("unroll") for (int n = 0; n < 2; ++n) _Pragma("unroll") for (int k = 0; k < 2; ++k) \
        acc[ai][bj][m][n] = __builtin_amdgcn_mfma_f32_16x16x32_bf16(Bt[n][k], At[m][k], acc[ai][bj][m][n], 0, 0, 0); __builtin_amdgcn_s_setprio(0); } while (0)
#define PG8_WAIT_V(n) asm volatile("s_waitcnt vmcnt(" #n ")" ::: "memory")
#define PG8_WAIT_L(n) asm volatile("s_waitcnt lgkmcnt(" #n ")" ::: "memory")
#define PG8_BAR __builtin_amdgcn_s_barrier()
#define PG8_SCHED __builtin_amdgcn_sched_barrier(0)
    Unit cur, nxt; int ui = 0;
    if (!S.next(0, cur)) return;
    f32x4 acc[2][2][4][2];
#pragma unroll
    for (int a = 0; a < 2; ++a)
#pragma unroll
        for (int b = 0; b < 2; ++b)
#pragma unroll
            for (int m = 0; m < 4; ++m)
#pragma unroll
                for (int n = 0; n < 2; ++n) acc[a][b][m][n] = (f32x4){0.f, 0.f, 0.f, 0.f};
    bf16x8 At[4][2], B0[2][2], B1[2][2];
    const char* cA = (const char*)g.A + (size_t)cur.pm * tstep; const char* cB = (const char*)g.Bt + (size_t)cur.pn * tstep;
    S.a_ready(cur);
    if constexpr (SP2) {
        PG8_STAGE(PG8_SB(0, 0), cB, voffB); PG8_STAGE(PG8_SB(0, 1), cB + hstep, voffB); PG8_STAGE(PG8_SA(0, 0), cA, voffA); PG8_STAGE(PG8_SA(0, 1), cA + hstep, voffA);
        if (wr == 1) PG8_BAR;
        PG8_WAIT_V(2); PG8_BAR;
        PG8_STAGE(PG8_SB(1, 0), cB + kstep, voffB); PG8_STAGE(PG8_SA(1, 0), cA + kstep, voffA); PG8_STAGE(PG8_SB(1, 1), cB + hstep + kstep, voffB);
        PG8_WAIT_V(6); PG8_BAR;
    } else {
        PG8_STAGE(PG8_SB(0, 0), cB, voffB); PG8_STAGE(PG8_SA(0, 0), cA, voffA); PG8_STAGE(PG8_SB(0, 1), cB + hstep, voffB); PG8_STAGE(PG8_SA(0, 1), cA + hstep, voffA);
        if (wr == 1) PG8_BAR;
        PG8_WAIT_V(4); PG8_BAR;
        PG8_STAGE(PG8_SB(1, 0), cB + kstep, voffB); PG8_STAGE(PG8_SA(1, 0), cA + kstep, voffA); PG8_STAGE(PG8_SB(1, 1), cB + hstep + kstep, voffB);
        PG8_WAIT_V(6); PG8_BAR;
    }
    for (;;) {
        const bool has_next = S.next(ui + 1, nxt);
        const char* nA = has_next ? (const char*)g.A + (size_t)nxt.pm * tstep : cA; const char* nB = has_next ? (const char*)g.Bt + (size_t)nxt.pn * tstep : cB;
        for (int t = 0; t < nt; t += 2) {
            const bool last = (t == nt - 2);
            const char* a1 = cA + (size_t)(t + 1) * kstep;
            const char* a2 = last ? nA : cA + (size_t)(t + 2) * kstep; const char* b2 = last ? nB : cB + (size_t)(t + 2) * kstep;
            const char* a3 = a2 + kstep; const char* b3 = b2 + kstep;
            if (last && has_next) S.a_ready(nxt);
            if constexpr (SP2) {
            PG8_LDB(B0, 0, 0); PG8_LDB(B1, 0, 1); PG8_SCHED; PG8_LDA(At, 0, 0); PG8_STAGE(PG8_SA(1, 1), a1 + hstep, voffA);
            PG8_WAIT_V(8); PG8_WAIT_L(0); PG8_BAR; PG8_MMA(0, 0, At, B0); PG8_MMA(0, 1, At, B1); PG8_BAR; PG8_SCHED;
            PG8_LDA(At, 0, 1); PG8_STAGE(PG8_SB(0, 0), b2, voffB); PG8_STAGE(PG8_SB(0, 1), b2 + hstep, voffB); PG8_STAGE(PG8_SA(0, 0), a2, voffA);
            PG8_WAIT_V(8); PG8_WAIT_L(0); PG8_BAR; PG8_MMA(1, 0, At, B0); PG8_MMA(1, 1, At, B1); PG8_BAR; PG8_SCHED;
            PG8_LDB(B0, 1, 0); PG8_LDB(B1, 1, 1); PG8_SCHED; PG8_LDA(At, 1, 0); PG8_STAGE(PG8_SA(0, 1), a2 + hstep, voffA);
            PG8_WAIT_V(8); PG8_WAIT_L(0); PG8_BAR; PG8_MMA(0, 0, At, B0); PG8_MMA(0, 1, At, B1); PG8_BAR; PG8_SCHED;
            PG8_LDA(At, 1, 1); PG8_STAGE(PG8_SB(1, 0), b3, voffB); PG8_STAGE(PG8_SB(1, 1), b3 + hstep, voffB); PG8_STAGE(PG8_SA(1, 0), a3, voffA);
            PG8_WAIT_V(8); PG8_WAIT_L(0); PG8_BAR; PG8_MMA(1, 0, At, B0); PG8_MMA(1, 1, At, B1); PG8_BAR; PG8_SCHED;
            } else {
            PG8_LDB(B0, 0, 0); PG8_SCHED; PG8_LDA(At, 0, 0); PG8_STAGE(PG8_SA(1, 1), a1 + hstep, voffA);
            PG8_WAIT_L(8); PG8_BAR; PG8_WAIT_L(0); PG8_MMA(0, 0, At, B0); PG8_BAR; PG8_SCHED;
            PG8_LDB(B1, 0, 1); PG8_STAGE(PG8_SB(0, 0), b2, voffB);
            PG8_BAR; PG8_WAIT_L(0); PG8_MMA(0, 1, At, B1); PG8_BAR;
            PG8_LDA(At, 0, 1); PG8_STAGE(PG8_SA(0, 0), a2, voffA);
            PG8_BAR; PG8_WAIT_L(0); PG8_MMA(1, 0, At, B0); PG8_BAR; PG8_SCHED;
            PG8_STAGE(PG8_SB(0, 1), b2 + hstep, voffB);
            PG8_WAIT_V(6); PG8_BAR; PG8_MMA(1, 1, At, B1); PG8_BAR;
            PG8_LDB(B0, 1, 0); PG8_SCHED; PG8_LDA(At, 1, 0); PG8_STAGE(PG8_SA(0, 1), a2 + hstep, voffA);
            PG8_WAIT_L(8); PG8_BAR; PG8_WAIT_L(0); PG8_MMA(0, 0, At, B0); PG8_BAR; PG8_SCHED;
            PG8_LDB(B1, 1, 1); PG8_STAGE(PG8_SB(1, 0), b3, voffB);
            PG8_BAR; PG8_WAIT_L(0); PG8_MMA(0, 1, At, B1); PG8_BAR;
            PG8_LDA(At, 1, 1); PG8_STAGE(PG8_SA(1, 0), a3, voffA);
            PG8_BAR; PG8_WAIT_L(0); PG8_MMA(1, 0, At, B0); PG8_BAR; PG8_SCHED;
            PG8_STAGE(PG8_SB(1, 1), b3 + hstep, voffB);
            PG8_WAIT_V(6); PG8_BAR; PG8_MMA(1, 1, At, B1); PG8_BAR;
            }
        }
        if constexpr (ALIGN_EPI) { if (wr == 0) PG8_BAR; }
        if constexpr (!Epi::AFTER_DRAIN) { E(acc, cur, wr, wc, fr, fq); S.done(cur); }
        if (!has_next) break;
#pragma unroll
        for (int a = 0; a < 2; ++a)
#pragma unroll
            for (int b = 0; b < 2; ++b)
#pragma unroll
                for (int m = 0; m < 4; ++m)
#pragma unroll
                    for (int n = 0; n < 2; ++n) acc[a][b][m][n] = (f32x4){0.f, 0.f, 0.f, 0.f};
        cur = nxt; cA = nA; cB = nB; ++ui;
        if constexpr (ALIGN_EPI) { if (wr == 1) PG8_BAR; }
    }
    PG8_WAIT_V(0);
    if constexpr (!ALIGN_EPI) { if (wr == 0) PG8_BAR; }
    PG8_BAR;
    if constexpr (Epi::AFTER_DRAIN) { E.fused(acc, cur, wr, wc, fr, fq, lds, wid, lane); S.done(cur); }
#undef PG8_SA
#undef PG8_SB
#undef PG8_STAGE
#undef PG8_LDA
#undef PG8_LDB
#undef PG8_MMA
#undef PG8_WAIT_V
#undef PG8_WAIT_L
#undef PG8_BAR
#undef PG8_SCHED
}
}
#define LAS __attribute__((address_space(3)))
typedef unsigned short bf16_t;
typedef short bf16x8 __attribute__((ext_vector_type(8)));
typedef float f32x4 __attribute__((ext_vector_type(4)));
typedef unsigned u32x4 __attribute__((ext_vector_type(4)));
typedef unsigned u32x2 __attribute__((ext_vector_type(2)));

constexpr int T = 16384, SEQ = 8192, D = 2048;
constexpr float EPS = 1e-6f;
constexpr int NSEG = 4, CSEG = 128 / NSEG;
constexpr size_t MiB = 1u << 20;
constexpr size_t WS_SS = 0;
constexpr size_t WS_GATES = 1 * MiB;
constexpr size_t WS_AA = 2 * MiB, WS_MM = WS_AA + 256 * 1024, WS_FF = WS_MM + 256 * 1024;
constexpr size_t WS_SEGN = 3 * MiB;
constexpr size_t WS_BAR = 3 * MiB + 64 * 1024;
constexpr size_t WS_USC = 3 * MiB + 256 * 1024, WS_VSC = WS_USC + 128 * 1024;
constexpr size_t WS_WIN = 4 * MiB;
constexpr size_t WS_WOUT = 28 * MiB;
constexpr size_t WS_WQKV = 36 * MiB;
constexpr size_t WS_WO = 46 * MiB;
constexpr size_t WS_WPQ = 54 * MiB;
constexpr size_t WS_WG = 70 * MiB;
constexpr size_t WS_WPR = 86 * MiB;
constexpr size_t WS_K1 = 88 * MiB, WS_K2 = 89 * MiB;
constexpr size_t WS_SEGST = 90 * MiB;
constexpr size_t WS_UB = 108 * MiB;
constexpr size_t WS_VB = 236 * MiB;
constexpr size_t WS_PB = 364 * MiB;
constexpr size_t WS_PP = 380 * MiB;
constexpr size_t WS_H = 444 * MiB;
constexpr size_t WS_HBA = 572 * MiB, WS_HBB = 636 * MiB;
constexpr size_t WS_R = 700 * MiB;
constexpr size_t WS_QK = WS_R;
constexpr size_t WS_OG = WS_R + 64 * MiB;
constexpr size_t WS_KVT = WS_R + 128 * MiB;
constexpr size_t WS_HM = WS_R + 224 * MiB;
constexpr size_t WS_EIDX = WS_R + 288 * MiB;
constexpr size_t WS_GW = WS_R + 296 * MiB;
constexpr size_t WS_QK2 = WS_R + 64 * MiB;
constexpr size_t WS_VT2 = WS_R + 136 * MiB;
constexpr size_t WS_O = WS_R + 144 * MiB;
constexpr size_t WS_SSP = WS_R + 304 * MiB;
constexpr size_t WS_SSQ = WS_R + 312 * MiB;
constexpr size_t WS_PA = WS_R + 64 * MiB;
constexpr size_t WS_CI = WS_R + 192 * MiB;
constexpr size_t WS_XQ = WS_R + 224 * MiB;
constexpr size_t WS_XS = WS_R + 256 * MiB;
constexpr size_t WS_END = WS_R + 316 * MiB;
constexpr int LDS_BYTES = 160 * 1024;

__device__ __forceinline__ unsigned pk2(float lo, float hi) { unsigned r; asm volatile("v_cvt_pk_bf16_f32 %0, %1, %2" : "=v"(r) : "v"(lo), "v"(hi)); return r; }
__device__ __forceinline__ float bflo(unsigned u) { return __uint_as_float(u << 16); }
__device__ __forceinline__ float bfhi(unsigned u) { return __uint_as_float(u & 0xffff0000u); }
__device__ __forceinline__ float wave_sum(float v) {
#pragma unroll
    for (int o = 1; o < 64; o <<= 1) v += __shfl_xor(v, o);
    return v;
}
__device__ __forceinline__ float rstd_of(float ss) { return 1.0f / sqrtf(ss * (1.0f / D) + EPS); }
__device__ __forceinline__ float sigmoidf_(float x) { return 1.0f / (1.0f + __expf(-x)); }
__device__ __forceinline__ f32x4 mfma16(bf16x8 a, bf16x8 b, f32x4 c) { return __builtin_amdgcn_mfma_f32_16x16x32_bf16(a, b, c, 0, 0, 0); }
__device__ __forceinline__ bf16x8 lfrag(const LAS unsigned char* base, int row, int stride, int kb) { return *(const LAS bf16x8*)(base + row * stride + kb); }
#define BLOCK_SYNC() __syncthreads()

struct Params { const float* in[23]; float* out; unsigned char* ws; int ph_lo, ph_hi; };
struct SSRef { const float* p; int n; };
__device__ __forceinline__ float ss_get(const SSRef s, int r) {
    if (s.n == 1) return s.p[r];
    const f32x4* q = (const f32x4*)(s.p + (size_t)r * s.n); f32x4 a = q[0];
    for (int i = 1; i < s.n / 4; ++i) a += q[i];
    return (a[0] + a[1]) + (a[2] + a[3]);
}
__device__ __forceinline__ float ss_get4(const SSRef s, int r, int fq) {
    if (s.n == 1) return s.p[r];
    const int per = s.n / 16; const f32x4* q = (const f32x4*)(s.p + (size_t)r * s.n) + fq * per; f32x4 a = q[0];
    for (int i = 1; i < per; ++i) a += q[i];
    float v = (a[0] + a[1]) + (a[2] + a[3]);
    v += __shfl_xor(v, 16); v += __shfl_xor(v, 32);
    return v;
}

struct EpiScale {
    static constexpr bool PERM = true, AFTER_DRAIN = false;
    bf16_t* O; int ldc; SSRef rss; SSRef css;
    __device__ __forceinline__ void operator()(const f32x4 (&acc)[2][2][4][2], const pg8::Unit& u, int wr, int wc, int fr, int fq) const {
        const int row0 = u.pm * 256 + wr * 64 + fr, col0 = u.pn * 256 + wc * 32 + 8 * fq;
        f32x4 cs[2][2];
#pragma unroll
        for (int bj = 0; bj < 2; ++bj)
#pragma unroll
            for (int n = 0; n < 2; ++n) {
                if (css.p) { const int c = col0 + bj * 128 + 4 * n; cs[bj][n] = (f32x4){rstd_of(ss_get(css, c)), rstd_of(ss_get(css, c + 1)), rstd_of(ss_get(css, c + 2)), rstd_of(ss_get(css, c + 3))}; }
                else cs[bj][n] = (f32x4){1.f, 1.f, 1.f, 1.f};
            }
#pragma unroll
        for (int ai = 0; ai < 2; ++ai)
#pragma unroll
            for (int m = 0; m < 4; ++m) {
                const int r = row0 + ai * 128 + m * 16;
                const float rs = rss.p ? rstd_of(ss_get4(rss, r, fq)) : 1.f;
                bf16_t* rowp = O + (size_t)r * ldc + col0;
#pragma unroll
                for (int bj = 0; bj < 2; ++bj) {
                    const f32x4 v0 = acc[ai][bj][m][0] * rs * cs[bj][0], v1 = acc[ai][bj][m][1] * rs * cs[bj][1];
                    u32x4 w; w.x = pk2(v0[0], v0[1]); w.y = pk2(v0[2], v0[3]); w.z = pk2(v1[0], v1[1]); w.w = pk2(v1[2], v1[3]);
                    *(u32x4*)(rowp + bj * 128) = w;
                }
            }
    }
};
template <bool GATE, bool HOLD32> struct EpiRes {
    static constexpr bool PERM = true, AFTER_DRAIN = false;
    const void* Hold; bf16_t* HB; float* SSout; const bf16_t* PP; SSRef rss;
    __device__ __forceinline__ void operator()(const f32x4 (&acc)[2][2][4][2], const pg8::Unit& u, int wr, int wc, int fr, int fq) const {
        const int row0 = u.pm * 256 + wr * 64 + fr, col0 = u.pn * 256 + wc * 32 + 8 * fq;
#pragma unroll
        for (int ai = 0; ai < 2; ++ai)
#pragma unroll
            for (int m = 0; m < 4; ++m) {
                const int r = row0 + ai * 128 + m * 16;
                float rs = 1.f; if (GATE) rs = rstd_of(ss_get4(rss, r, fq));
                float ssp = 0.f;
#pragma unroll
                for (int bj = 0; bj < 2; ++bj) {
                    const size_t off = (size_t)r * D + col0 + bj * 128;
                    f32x4 a0 = acc[ai][bj][m][0], a1 = acc[ai][bj][m][1];
                    if (GATE) {
                        const u32x4 pp = *(const u32x4*)(PP + off);
                        a0 = (f32x4){sigmoidf_(a0[0] * rs) * bflo(pp.x), sigmoidf_(a0[1] * rs) * bfhi(pp.x), sigmoidf_(a0[2] * rs) * bflo(pp.y), sigmoidf_(a0[3] * rs) * bfhi(pp.y)};
                        a1 = (f32x4){sigmoidf_(a1[0] * rs) * bflo(pp.z), sigmoidf_(a1[1] * rs) * bfhi(pp.z), sigmoidf_(a1[2] * rs) * bflo(pp.w), sigmoidf_(a1[3] * rs) * bfhi(pp.w)};
                    }
                    f32x4 h0, h1;
                    if (HOLD32) { h0 = *(const f32x4*)((const float*)Hold + off); h1 = *(const f32x4*)((const float*)Hold + off + 4); }
                    else { const u32x4 hb = *(const u32x4*)((const bf16_t*)Hold + off); h0 = (f32x4){bflo(hb.x), bfhi(hb.x), bflo(hb.y), bfhi(hb.y)}; h1 = (f32x4){bflo(hb.z), bfhi(hb.z), bflo(hb.w), bfhi(hb.w)}; }
                    const f32x4 v0 = h0 + a0, v1 = h1 + a1;
                    { u32x4 w; w.x = pk2(v0[0], v0[1]); w.y = pk2(v0[2], v0[3]); w.z = pk2(v1[0], v1[1]); w.w = pk2(v1[2], v1[3]); *(u32x4*)(HB + off) = w; }
                    ssp += (v0[0] * v0[0] + v0[1] * v0[1]) + (v0[2] * v0[2] + v0[3] * v0[3]) + (v1[0] * v1[0] + v1[1] * v1[1]) + (v1[2] * v1[2] + v1[3] * v1[3]);
                }
                ssp += __shfl_xor(ssp, 16); ssp += __shfl_xor(ssp, 32);
                if (fq == 0) SSout[(size_t)r * 32 + u.pn * 4 + wc] = ssp;
                asm volatile("" ::: "memory");
            }
    }
};
template <class Epi> __device__ __forceinline__ void run_gemm(LAS unsigned char* lds, const bf16_t* A, const bf16_t* Bt, int M, int N, int K, const Epi& E, const int rot = 0) {
    const int G = (int)gridDim.x; pg8::Gemm g{A, Bt, M, N, K}; pg8::StaticOrder S; S.init(M, N, G, ((int)blockIdx.x + G - (rot % G)) % G);
    pg8::gemm_phase<Epi, pg8::StaticOrder, true, true>(lds, g, S, E);
}

__device__ __forceinline__ bool tr_job(int& r, const float* W, int ldw, int K, int col_off, int ncols, bf16_t* WT, const float* normw, int climit, float cscale, LAS float* scr, int lane) {
    const int nblk = ncols / 64, items = (K / 64) * nblk;
    if (r >= items) { r -= items; return false; }
    const int kb = r / nblk, nb = r % nblk, k0 = 64 * kb, n0 = 64 * nb;
    f32x4 v[16];
#pragma unroll
    for (int i = 0; i < 16; ++i) { const int kk = 4 * i + (lane >> 4); v[i] = *(const f32x4*)(W + (size_t)(k0 + kk) * ldw + col_off + n0 + (lane & 15) * 4); }
#pragma unroll
    for (int i = 0; i < 16; ++i) { const int kk = 4 * i + (lane >> 4); const float nw = normw ? normw[k0 + kk] : 1.f; LAS float* d = scr + kk * 65 + (lane & 15) * 4;
        d[0] = v[i][0] * nw; d[1] = v[i][1] * nw; d[2] = v[i][2] * nw; d[3] = v[i][3] * nw; }
    asm volatile("s_waitcnt lgkmcnt(0)" ::: "memory");
    const int c = lane & 7;
#pragma unroll
    for (int j = 0; j < 8; ++j) { const int n = (lane >> 3) + 8 * j; const LAS float* sp = scr + (8 * c) * 65 + n; const float sc = (n0 + n) < climit ? cscale : 1.f;
        u32x4 o; o.x = pk2(sp[0 * 65] * sc, sp[1 * 65] * sc); o.y = pk2(sp[2 * 65] * sc, sp[3 * 65] * sc); o.z = pk2(sp[4 * 65] * sc, sp[5 * 65] * sc); o.w = pk2(sp[6 * 65] * sc, sp[7 * 65] * sc);
        *(u32x4*)(WT + (size_t)(n0 + n) * K + k0 + 8 * c) = o; }
    asm volatile("s_waitcnt lgkmcnt(0)" ::: "memory");
    return true;
}
__device__ __forceinline__ void cvt_flat(const float* src, bf16_t* dst, size_t n8, size_t gtid, size_t gthreads) {
    for (size_t i = gtid; i < n8; i += gthreads) { const f32x4 a = *(const f32x4*)(src + i * 8), b = *(const f32x4*)(src + i * 8 + 4);
        u32x4 w; w.x = pk2(a[0], a[1]); w.y = pk2(a[2], a[3]); w.z = pk2(b[0], b[1]); w.w = pk2(b[2], b[3]); *(u32x4*)(dst + i * 8) = w; }
}
typedef float f32x2 __attribute__((ext_vector_type(2)));
__device__ __forceinline__ void cvt_rows_fp8(const float* src, unsigned char* dst, float* inv, int rbeg, int nrows, int gw, int NGW, int lane, const int bias) {
    for (int r0 = rbeg + gw; r0 < nrows; r0 += 2 * NGW) {
        f32x4 v[2][8];
#pragma unroll
        for (int u = 0; u < 2; ++u) { const int r = r0 + u * NGW; if (r < nrows) { const f32x4* xr = (const f32x4*)(src + (size_t)r * 2048) + lane;
#pragma unroll
            for (int j = 0; j < 8; ++j) v[u][j] = xr[64 * j]; } }
#pragma unroll
        for (int u = 0; u < 2; ++u) { const int r = r0 + u * NGW; if (r < nrows) {
            float am = 0.f;
#pragma unroll
            for (int j = 0; j < 8; ++j) am = fmaxf(am, fmaxf(fmaxf(fabsf(v[u][j][0]), fabsf(v[u][j][1])), fmaxf(fabsf(v[u][j][2]), fabsf(v[u][j][3]))));
#pragma unroll
            for (int o = 1; o < 64; o <<= 1) am = fmaxf(am, __shfl_xor(am, o));
            const float sc = am > 0.f ? 127.0f / am : 0.f;
            const int layer = r >> 14, rl = r & 16383;
#pragma unroll
            for (int j = 0; j < 8; ++j) {
                const unsigned u0 = (unsigned)((int)rintf(v[u][j][0] * sc) + bias) & 255u, u1 = (unsigned)((int)rintf(v[u][j][1] * sc) + bias) & 255u, u2 = (unsigned)((int)rintf(v[u][j][2] * sc) + bias) & 255u, u3 = (unsigned)((int)rintf(v[u][j][3] * sc) + bias) & 255u;
                *(unsigned*)(dst + ((size_t)(layer * 16 + 2 * j + (lane >> 5)) * 16384 + rl) * 128 + 4 * (lane & 31)) = u0 | (u1 << 8) | (u2 << 16) | (u3 << 24); }
            if (lane == 0) inv[r] = am * (1.0f / 127.0f);
        } }
    }
}
__device__ __forceinline__ void p0_prologue(const Params& p, LAS unsigned char* lds) {
    const int tid = threadIdx.x, lane = tid & 63, wave = tid >> 6;
    const int gw = blockIdx.x * 8 + wave, NGW = gridDim.x * 8;
    unsigned char* ws = p.ws;
    LAS float* GT = (LAS float*)lds;
    for (int i = tid; i < 2048 * 8; i += 512) { const int k = i >> 3, g = i & 7; GT[i] = p.in[2][k] * p.in[3][(size_t)k * 6152 + 6144 + g]; }
    BLOCK_SYNC();
    { float* SS = (float*)(ws + WS_SS); float* GATES = (float*)(ws + WS_GATES); bf16_t* HBA = (bf16_t*)(ws + WS_HBA);
      f32x4 vn[8];
      if (gw < T) {
#pragma unroll
          for (int j = 0; j < 8; ++j) vn[j] = *((const f32x4*)(p.in[0] + (size_t)gw * D) + lane + 64 * j); }
      for (int m = gw; m < T; m += NGW) {
        f32x4 v[8]; float s = 0.f;
#pragma unroll
        for (int j = 0; j < 8; ++j) v[j] = vn[j];
        if (m + NGW < T) {
#pragma unroll
            for (int j = 0; j < 8; ++j) vn[j] = *((const f32x4*)(p.in[0] + (size_t)(m + NGW) * D) + lane + 64 * j); }
#pragma unroll
        for (int j = 0; j < 8; ++j) s += (v[j][0] * v[j][0] + v[j][1] * v[j][1]) + (v[j][2] * v[j][2] + v[j][3] * v[j][3]);
        s = wave_sum(s);
        const float rs = rstd_of(s);
        float ga[8];
#pragma unroll
        for (int g = 0; g < 8; ++g) ga[g] = 0.f;
#pragma unroll
        for (int j = 0; j < 8; ++j) {
            *(u32x2*)(HBA + (size_t)m * D + 256 * j + 4 * lane) = (u32x2){pk2(v[j][0], v[j][1]), pk2(v[j][2], v[j][3])};
#pragma unroll
            for (int e = 0; e < 4; ++e) { const int k = 256 * j + 4 * lane + e; const f32x4 g0 = *(const LAS f32x4*)(GT + k * 8), g1 = *(const LAS f32x4*)(GT + k * 8 + 4); const float xv = v[j][e];
                ga[0] += xv * g0[0]; ga[1] += xv * g0[1]; ga[2] += xv * g0[2]; ga[3] += xv * g0[3]; ga[4] += xv * g1[0]; ga[5] += xv * g1[1]; ga[6] += xv * g1[2]; ga[7] += xv * g1[3]; }
        }
#pragma unroll
        for (int g = 0; g < 8; ++g) ga[g] = wave_sum(ga[g]) * rs;
        if (lane == 0) { SS[m] = s; *(f32x4*)(GATES + (size_t)m * 8) = (f32x4){ga[0], ga[1], ga[2], ga[3]}; *(f32x4*)(GATES + (size_t)m * 8 + 4) = (f32x4){ga[4], ga[5], ga[6], ga[7]}; }
      } }
    BLOCK_SYNC();
    { LAS float* scr = (LAS float*)(lds + wave * 16640);
      const bool split = (gridDim.x == 256);
      const int NITEMS = 32 * 96 + 32 * 32 + 32 * 32 + 32 * 4 + 32 * 4 + 32 * 32 + 2 * 32 * 32 + 2 * 32 * 32 + 2 * 4 * 32 - (split ? 3 * 32 * 32 : 0);
      for (int it = gw; it < NITEMS; it += NGW) {
        int r = it;
        if (tr_job(r, p.in[3], 6152, 2048, 0, 6144, (bf16_t*)(ws + WS_WIN), p.in[2], 1024, 0.0625f, scr, lane)) continue;
        if (tr_job(r, p.in[6], 2048, 2048, 0, 2048, (bf16_t*)(ws + WS_WOUT), nullptr, 0, 1.f, scr, lane)) continue;
        if (tr_job(r, p.in[10], 2048, 2048, 0, 2048, (bf16_t*)(ws + WS_WQKV), p.in[9], 2048, 0.125f, scr, lane)) continue;
        if (tr_job(r, p.in[8], 512, 2048, 0, 256, (bf16_t*)(ws + WS_WQKV) + (size_t)2048 * 2048, p.in[7], 0, 1.f, scr, lane)) continue;
        if (tr_job(r, p.in[8], 512, 2048, 256, 256, (bf16_t*)(ws + WS_WQKV) + (size_t)2304 * 2048, p.in[7], 0, 1.f, scr, lane)) continue;
        if (!split) if (tr_job(r, p.in[12], 2048, 2048, 0, 2048, (bf16_t*)(ws + WS_WO), nullptr, 0, 1.f, scr, lane)) continue;
        if (tr_job(r, p.in[14], 2048, 2048, 0, 2048, (bf16_t*)(ws + WS_WPQ), p.in[13], 0, 1.f, scr, lane)) continue;
        if (!split) if (tr_job(r, p.in[14] + (size_t)D * D, 2048, 2048, 0, 2048, (bf16_t*)(ws + WS_WPQ) + (size_t)D * D, p.in[13] + D, 0, 1.f, scr, lane)) continue;
        if (tr_job(r, p.in[20], 2048, 2048, 0, 2048, (bf16_t*)(ws + WS_WG), p.in[19], 0, 1.f, scr, lane)) continue;
        if (!split) if (tr_job(r, p.in[20] + (size_t)D * D, 2048, 2048, 0, 2048, (bf16_t*)(ws + WS_WG) + (size_t)D * D, p.in[19] + D, 0, 1.f, scr, lane)) continue;
        if (tr_job(r, p.in[21], 2048, 256, 0, 2048, (bf16_t*)(ws + WS_WPR), nullptr, 0, 1.f, scr, lane)) continue;
        tr_job(r, p.in[21] + (size_t)256 * D, 2048, 256, 0, 2048, (bf16_t*)(ws + WS_WPR) + (size_t)D * 256, nullptr, 0, 1.f, scr, lane);
      } }
    { const size_t gtid = (size_t)blockIdx.x * 512 + tid, gth = (size_t)gridDim.x * 512;
      const int nconv = (gridDim.x == 256) ? 16384 : 2 * 16384;
      cvt_rows_fp8(p.in[17], ws + WS_UB, (float*)(ws + WS_USC), 0, nconv, gw, NGW, lane, 0);
      cvt_rows_fp8(p.in[18], ws + WS_VB, (float*)(ws + WS_VSC), 0, nconv, gw, NGW, lane, 0);
      cvt_flat(p.in[1], (bf16_t*)(ws + WS_PB), (size_t)2 * T * 256 / 8, gtid, gth);
      cvt_flat(p.in[15], (bf16_t*)(ws + WS_K1), (size_t)2 * 8 * 128 * 128 / 8, gtid, gth);
      cvt_flat(p.in[16], (bf16_t*)(ws + WS_K2), (size_t)2 * 8 * 128 * 128 / 8, gtid, gth); }
}

__device__ __forceinline__ float block_scan_add(float v, LAS float* red, int tid) {
    const int lane = tid & 63, wave = tid >> 6; float inc = v;
#pragma unroll
    for (int o = 1; o < 64; o <<= 1) { const float t = __shfl_up(inc, o); if (lane >= o) inc += t; }
    BLOCK_SYNC(); if (lane == 63) red[wave] = inc; BLOCK_SYNC();
    float off = 0.f; for (int w = 0; w < wave; ++w) off += red[w];
    return off + inc - v;
}
__device__ __forceinline__ float block_scan_max(float v, LAS float* red, int tid) {
    const int lane = tid & 63, wave = tid >> 6; float inc = v;
#pragma unroll
    for (int o = 1; o < 64; o <<= 1) { const float t = __shfl_up(inc, o); if (lane >= o) inc = fmaxf(inc, t); }
    BLOCK_SYNC(); if (lane == 63) red[wave] = inc; BLOCK_SYNC();
    float off = -INFINITY; for (int w = 0; w < wave; ++w) off = fmaxf(off, red[w]);
    const float prev = __shfl_up(inc, 1);
    return fmaxf(off, lane == 0 ? -INFINITY : prev);
}
__device__ __forceinline__ float softcap(float t) { return 15.0f * tanhf(t * (1.0f / 15.0f)); }
__device__ __forceinline__ float logsigmoid(float x) { return x >= 0.f ? -log1pf(expf(-x)) : x - log1pf(expf(x)); }
__device__ __forceinline__ void gate_prefix(const Params& p, LAS unsigned char* lds, int seq) {
    const int tid = threadIdx.x; const int b = seq >> 2, h = seq & 3;
    const float* GATES = (const float*)(p.ws + WS_GATES); const float* gb = p.in[4];
    float* AA = (float*)(p.ws + WS_AA) + seq * SEQ; float* MMp = (float*)(p.ws + WS_MM) + seq * SEQ; float* FFp = (float*)(p.ws + WS_FF) + seq * SEQ;
    LAS float* red = (LAS float*)lds;
    float li[16], lf[16]; float run = 0.f;
#pragma unroll
    for (int i = 0; i < 16; ++i) { const int t = tid * 16 + i; const size_t row = (size_t)b * SEQ + t;
        li[i] = softcap(GATES[row * 8 + h] + gb[h]); run += logsigmoid(softcap(GATES[row * 8 + 4 + h] + gb[4 + h])); lf[i] = run; }
    const float off = block_scan_add(run, red, tid);
    float cm = -INFINITY;
#pragma unroll
    for (int i = 0; i < 16; ++i) { lf[i] += off; li[i] = li[i] - lf[i]; cm = fmaxf(cm, li[i]); }
    const float offm = fmaxf(0.f, block_scan_max(cm, red + 16, tid));
    float rm = offm;
#pragma unroll
    for (int i = 0; i < 16; ++i) { const int t = tid * 16 + i; rm = fmaxf(rm, li[i]); AA[t] = li[i]; MMp[t] = rm; FFp[t] = lf[i]; }
    BLOCK_SYNC();
}

constexpr int ML_Q = 0, ML_K = 33792, ML_P = 67584, ML_VTW = 76800, ML_VT = 86016, ML_GT = 95232, ML_VEC = 129024;
__device__ __forceinline__ void mlstm_item(const Params& p, LAS unsigned char* lds, int seq, int slice, int seg, bool full) {
    const int tid = threadIdx.x, lane = tid & 63, w = tid >> 6, fr = lane & 15, g = lane >> 4;
    const int b = seq >> 2, h = seq & 3;
    unsigned char* ws = p.ws;
    const bf16_t* QK = (const bf16_t*)(ws + WS_QK); const bf16_t* VTg = (const bf16_t*)(ws + WS_KVT); bf16_t* HM = (bf16_t*)(ws + WS_HM);
    const float* AA = (const float*)(ws + WS_AA) + seq * SEQ; const float* MMp = (const float*)(ws + WS_MM) + seq * SEQ; const float* FFp = (const float*)(ws + WS_FF) + seq * SEQ;
    float* SEGST = (float*)(ws + WS_SEGST); float* SEGN = (float*)(ws + WS_SEGN);
    LAS float* Av = (LAS float*)(lds + ML_VEC); LAS float* Mv = Av + 64; LAS float* Fv = Av + 128; LAS float* Wv = Av + 192; LAS float* QN = Av + 256; LAS float* DENP = Av + 320; LAS float* NV = Av + 576;
    f32x4 accG[4][2];
#pragma unroll
    for (int dvt = 0; dvt < 4; ++dvt)
#pragma unroll
        for (int a = 0; a < 2; ++a) accG[dvt][a] = (f32x4){0.f, 0.f, 0.f, 0.f};
    float nreg[2] = {0.f, 0.f};
    if (full && seg > 0) {
        const float Mref = MMp[seg * CSEG * 64 - 1];
        for (int s2 = 0; s2 < seg; ++s2) {
            const float sc = expf(MMp[(s2 + 1) * CSEG * 64 - 1] - Mref);
            const float* st = SEGST + ((size_t)((seq * NSEG + s2) * 8 + slice)) * 16384;
#pragma unroll
            for (int dvt = 0; dvt < 4; ++dvt)
#pragma unroll
                for (int a = 0; a < 2; ++a) accG[dvt][a] += *(const f32x4*)(st + ((2 * w + a) * 16 + fr) * 64 + dvt * 16 + g * 4) * sc;
#pragma unroll
            for (int a = 0; a < 2; ++a) nreg[a] += sc * SEGN[(seq * NSEG + s2) * 256 + (2 * w + a) * 16 + fr];
        }
    }
    if (g == 0) { NV[(2 * w) * 16 + fr] = nreg[0]; NV[(2 * w + 1) * 16 + fr] = nreg[1]; }
#define ML_GT_WRITE() do { _Pragma("unroll") for (int dvt = 0; dvt < 4; ++dvt) _Pragma("unroll") for (int a = 0; a < 2; ++a) { \
        const unsigned lo_ = pk2(accG[dvt][a][0], accG[dvt][a][1]), hi_ = pk2(accG[dvt][a][2], accG[dvt][a][3]); \
        LAS unsigned char* gp_ = lds + ML_GT + (dvt * 16 + g * 4) * 528 + ((2 * w + a) * 16 + fr) * 2; \
        *(LAS bf16_t*)(gp_) = (bf16_t)(lo_ & 0xffffu); *(LAS bf16_t*)(gp_ + 528) = (bf16_t)(lo_ >> 16); *(LAS bf16_t*)(gp_ + 2 * 528) = (bf16_t)(hi_ & 0xffffu); *(LAS bf16_t*)(gp_ + 3 * 528) = (bf16_t)(hi_ >> 16); } } while (0)
    ML_GT_WRITE();
    const int c0 = seg * CSEG, c1 = c0 + CSEG;
#define ML_BAR() do { asm volatile("s_waitcnt lgkmcnt(0)" ::: "memory"); __builtin_amdgcn_s_barrier(); asm volatile("" ::: "memory"); } while (0)
    u32x4 pkk[4], pvt; float pa = 0.f, pmv = 0.f, pf = 0.f, pMprev = 0.f, pMend = 0.f;
#define ML_ISSUE_KV(cc_) do { const int c_ = (cc_); const size_t tk_ = (size_t)b * SEQ + (size_t)c_ * 64; \
        if (!full) { _Pragma("unroll") for (int i = 0; i < 4; ++i) { const int q_ = tid + 512 * i, row_ = q_ >> 5, c8_ = q_ & 31; pkk[i] = *(const u32x4*)(QK + (tk_ + row_) * 2048 + 1024 + h * 256 + c8_ * 8); } } \
        { const int row_ = tid >> 3, c8_ = tid & 7; pvt = *(const u32x4*)(VTg + (size_t)(h * 512 + slice * 64 + row_) * T + tk_ + c8_ * 8); } \
        if (tid < 64) { pa = AA[c_ * 64 + tid]; pmv = MMp[c_ * 64 + tid]; pf = FFp[c_ * 64 + tid]; } \
        pMprev = (c_ == 0) ? 0.f : MMp[c_ * 64 - 1]; pMend = MMp[c_ * 64 + 63]; } while (0)
    ML_ISSUE_KV(c0);
    BLOCK_SYNC();
    for (int c = c0; c < c1; ++c) {
        const size_t tok0 = (size_t)b * SEQ + (size_t)c * 64;
        if (full) {
#pragma unroll
            for (int i = 0; i < 4; ++i) { const int q = tid + 512 * i, row = q >> 5, cc = q & 31;
                const u32x4 vq = *(const u32x4*)(QK + (tok0 + row) * 2048 + h * 256 + cc * 8);
                const u32x4 vk = *(const u32x4*)(QK + (tok0 + row) * 2048 + 1024 + h * 256 + cc * 8);
                *(LAS u32x4*)(lds + ML_Q + row * 528 + cc * 16) = vq; *(LAS u32x4*)(lds + ML_K + row * 528 + cc * 16) = vk; }
        } else {
#pragma unroll
            for (int i = 0; i < 4; ++i) { const int q = tid + 512 * i, row = q >> 5, cc = q & 31; *(LAS u32x4*)(lds + ML_K + row * 528 + cc * 16) = pkk[i]; }
        }
        { const int row = tid >> 3, cc = tid & 7; *(LAS u32x4*)(lds + ML_VT + row * 144 + cc * 16) = pvt; }
        if (tid < 64) { Av[tid] = pa; Mv[tid] = pmv; Fv[tid] = pf; }
        const float Mprev = pMprev, Mend = pMend;
        if (c + 1 < c1) ML_ISSUE_KV(c + 1);
        ML_BAR();
        if (tid < 64) Wv[tid] = expf(Av[tid] - Mend);
        f32x4 sacc[2];
        const int jt = w >> 1, tt0 = 2 * (w & 1);
        if (full) {
#pragma unroll
            for (int u = 0; u < 2; ++u) { sacc[u] = (f32x4){0.f, 0.f, 0.f, 0.f}; const int tt = tt0 + u;
                if (jt <= tt) {
#pragma unroll
                    for (int ks = 0; ks < 8; ++ks) sacc[u] = mfma16(lfrag(lds + ML_K, jt * 16 + fr, 528, ks * 64 + g * 16), lfrag(lds + ML_Q, tt * 16 + fr, 528, ks * 64 + g * 16), sacc[u]);
                } }
        }
        ML_BAR();
        { const int row = tid >> 3, cc = tid & 7;
            const u32x4 v = *(const LAS u32x4*)(lds + ML_VT + row * 144 + cc * 16); const LAS float* wj = Wv + cc * 8;
            u32x4 o; o.x = pk2(bflo(v.x) * wj[0], bfhi(v.x) * wj[1]); o.y = pk2(bflo(v.y) * wj[2], bfhi(v.y) * wj[3]); o.z = pk2(bflo(v.z) * wj[4], bfhi(v.z) * wj[5]); o.w = pk2(bflo(v.w) * wj[6], bfhi(v.w) * wj[7]);
            *(LAS u32x4*)(lds + ML_VTW + row * 144 + cc * 16) = o; }
        if (full) {
#pragma unroll
            for (int u = 0; u < 2; ++u) { const int tt = tt0 + u, t = tt * 16 + fr; const float Mt = Mv[t]; float pv[4]; float rsum = 0.f;
#pragma unroll
                for (int i = 0; i < 4; ++i) { const int j = jt * 16 + g * 4 + i; pv[i] = (j <= t) ? sacc[u][i] * __expf(Av[j] - Mt) : 0.f; rsum += pv[i]; }
                rsum += __shfl_xor(rsum, 16); rsum += __shfl_xor(rsum, 32);
                if (g == 0) DENP[jt * 64 + t] = rsum;
                *(LAS u32x2*)(lds + ML_P + t * 144 + (jt * 16 + g * 4) * 2) = (u32x2){pk2(pv[0], pv[1]), pk2(pv[2], pv[3])}; }
            { const int t = tid >> 3, part = tid & 7; float sq = 0.f;
#pragma unroll
                for (int i = 0; i < 4; ++i) { const u32x4 qv = *(const LAS u32x4*)(lds + ML_Q + t * 528 + part * 64 + i * 16); const LAS float* nn = NV + part * 32 + i * 8;
                    sq += bflo(qv.x) * nn[0] + bfhi(qv.x) * nn[1] + bflo(qv.y) * nn[2] + bfhi(qv.y) * nn[3] + bflo(qv.z) * nn[4] + bfhi(qv.z) * nn[5] + bflo(qv.w) * nn[6] + bfhi(qv.w) * nn[7]; }
                sq += __shfl_xor(sq, 1); sq += __shfl_xor(sq, 2); sq += __shfl_xor(sq, 4);
                if (part == 0) QN[t] = sq; }
        }
        ML_BAR();
        if (full) {
            const int tt = w >> 1, dvt0 = 2 * (w & 1);
            f32x4 a1[2], a2[2];
#pragma unroll
            for (int u = 0; u < 2; ++u) { a1[u] = (f32x4){0.f, 0.f, 0.f, 0.f}; a2[u] = (f32x4){0.f, 0.f, 0.f, 0.f}; }
#pragma unroll
            for (int ks = 0; ks < 8; ++ks) { const bf16x8 a = lfrag(lds + ML_Q, tt * 16 + fr, 528, ks * 64 + g * 16);
#pragma unroll
                for (int u = 0; u < 2; ++u) a1[u] = mfma16(a, lfrag(lds + ML_GT, (dvt0 + u) * 16 + fr, 528, ks * 64 + g * 16), a1[u]); }
#pragma unroll
            for (int ks = 0; ks < 2; ++ks) { const bf16x8 a = lfrag(lds + ML_P, tt * 16 + fr, 144, ks * 64 + g * 16);
#pragma unroll
                for (int u = 0; u < 2; ++u) a2[u] = mfma16(a, lfrag(lds + ML_VT, (dvt0 + u) * 16 + fr, 144, ks * 64 + g * 16), a2[u]); }
#pragma unroll
            for (int i = 0; i < 4; ++i) { const int t = tt * 16 + g * 4 + i; const float Mt = Mv[t]; const float wi = __expf(Mprev - Mt);
                const float den = wi * QN[t] + ((DENP[t] + DENP[64 + t]) + (DENP[128 + t] + DENP[192 + t]));
                const float inv = 1.0f / fmaxf(fabsf(den), __expf(-(Fv[t] + Mt)));
#pragma unroll
                for (int u = 0; u < 2; ++u) { const float hv = (wi * a1[u][i] + a2[u][i]) * inv;
                    HM[(tok0 + t) * 2048 + h * 512 + slice * 64 + (dvt0 + u) * 16 + fr] = (bf16_t)(pk2(hv, 0.f) & 0xffffu); } }
        }
        { const float decay = expf(Mprev - Mend);
#pragma unroll
            for (int dvt = 0; dvt < 4; ++dvt)
#pragma unroll
                for (int a = 0; a < 2; ++a) accG[dvt][a] = accG[dvt][a] * decay;
            f32x4 accN[2] = {(f32x4){0.f, 0.f, 0.f, 0.f}, (f32x4){0.f, 0.f, 0.f, 0.f}};
#pragma unroll
            for (int ks = 0; ks < 2; ++ks) {
                bf16x8 kf[2];
#pragma unroll
                for (int a = 0; a < 2; ++a) { const LAS unsigned char* kp = lds + ML_K + (ks * 32 + g * 8) * 528 + ((2 * w + a) * 16 + fr) * 2;
                    const unsigned e0 = *(const LAS bf16_t*)(kp), e1 = *(const LAS bf16_t*)(kp + 528), e2 = *(const LAS bf16_t*)(kp + 2 * 528), e3 = *(const LAS bf16_t*)(kp + 3 * 528);
                    const unsigned e4 = *(const LAS bf16_t*)(kp + 4 * 528), e5 = *(const LAS bf16_t*)(kp + 5 * 528), e6 = *(const LAS bf16_t*)(kp + 6 * 528), e7 = *(const LAS bf16_t*)(kp + 7 * 528);
                    kf[a] = __builtin_bit_cast(bf16x8, (u32x4){e0 | (e1 << 16), e2 | (e3 << 16), e4 | (e5 << 16), e6 | (e7 << 16)}); }
                const LAS float* wp = Wv + ks * 32 + g * 8;
                u32x4 wq = (u32x4){pk2(wp[0], wp[1]), pk2(wp[2], wp[3]), pk2(wp[4], wp[5]), pk2(wp[6], wp[7])};
                if (fr != 0) wq = (u32x4){0u, 0u, 0u, 0u};
                const bf16x8 wf = __builtin_bit_cast(bf16x8, wq);
#pragma unroll
                for (int dvt = 0; dvt < 4; ++dvt) { const bf16x8 vb = lfrag(lds + ML_VTW, dvt * 16 + fr, 144, ks * 64 + g * 16);
                    accG[dvt][0] = mfma16(vb, kf[0], accG[dvt][0]); accG[dvt][1] = mfma16(vb, kf[1], accG[dvt][1]); }
                accN[0] = mfma16(wf, kf[0], accN[0]); accN[1] = mfma16(wf, kf[1], accN[1]);
            }
            nreg[0] = decay * nreg[0] + accN[0][0]; nreg[1] = decay * nreg[1] + accN[1][0]; }
        ML_BAR();
        if (g == 0) { NV[(2 * w) * 16 + fr] = nreg[0]; NV[(2 * w + 1) * 16 + fr] = nreg[1]; }
        if (full) ML_GT_WRITE();
    }
    if (!full) {
        float* st = SEGST + ((size_t)((seq * NSEG + seg) * 8 + slice)) * 16384;
#pragma unroll
        for (int dvt = 0; dvt < 4; ++dvt)
#pragma unroll
            for (int a = 0; a < 2; ++a) *(f32x4*)(st + ((2 * w + a) * 16 + fr) * 64 + dvt * 16 + g * 4) = accG[dvt][a];
        if (slice == 0 && g == 0) { SEGN[(seq * NSEG + seg) * 256 + (2 * w) * 16 + fr] = nreg[0]; SEGN[(seq * NSEG + seg) * 256 + (2 * w + 1) * 16 + fr] = nreg[1]; }
    }
    BLOCK_SYNC();
#undef ML_GT_WRITE
}

__device__ __forceinline__ void headnorm_phase(const Params& p) {
    const int lane = threadIdx.x & 63, gw = blockIdx.x * 8 + (threadIdx.x >> 6), NGW = gridDim.x * 8;
    const bf16_t* HM = (const bf16_t*)(p.ws + WS_HM); const bf16_t* OG = (const bf16_t*)(p.ws + WS_OG); bf16_t* HG = (bf16_t*)(p.ws + WS_QK);
    const float* hn = p.in[5];
    for (int it0 = gw; it0 < T * 4; it0 += 4 * NGW) {
        u32x4 hv[4], ov[4];
#pragma unroll
        for (int u = 0; u < 4; ++u) { const int it = it0 + u * NGW; if (it < T * 4) { const size_t off = (size_t)(it >> 2) * 2048 + (it & 3) * 512 + lane * 8; hv[u] = *(const u32x4*)(HM + off); ov[u] = *(const u32x4*)(OG + off); } }
#pragma unroll
        for (int u = 0; u < 4; ++u) { const int it = it0 + u * NGW; if (it < T * 4) {
            const size_t off = (size_t)(it >> 2) * 2048 + (it & 3) * 512 + lane * 8;
            float x[8] = {bflo(hv[u].x), bfhi(hv[u].x), bflo(hv[u].y), bfhi(hv[u].y), bflo(hv[u].z), bfhi(hv[u].z), bflo(hv[u].w), bfhi(hv[u].w)};
            float o[8] = {bflo(ov[u].x), bfhi(ov[u].x), bflo(ov[u].y), bfhi(ov[u].y), bflo(ov[u].z), bfhi(ov[u].z), bflo(ov[u].w), bfhi(ov[u].w)};
            float sq = 0.f;
#pragma unroll
            for (int i = 0; i < 8; ++i) sq += x[i] * x[i];
            sq = wave_sum(sq);
            const float rs = 1.0f / sqrtf(sq * (1.0f / 512.0f) + EPS);
            const f32x4 n0 = *(const f32x4*)(hn + (it & 3) * 512 + lane * 8), n1 = *(const f32x4*)(hn + (it & 3) * 512 + lane * 8 + 4);
            float y[8];
#pragma unroll
            for (int i = 0; i < 8; ++i) y[i] = x[i] * rs * (i < 4 ? n0[i] : n1[i - 4]) * sigmoidf_(o[i]);
            *(u32x4*)(HG + off) = (u32x4){pk2(y[0], y[1]), pk2(y[2], y[3]), pk2(y[4], y[5]), pk2(y[6], y[7])};
        } }
    }
}

__device__ __forceinline__ void bsort16(unsigned (&v)[16]) {
#pragma unroll
    for (int k = 2; k <= 16; k <<= 1)
#pragma unroll
        for (int j = k >> 1; j > 0; j >>= 1)
#pragma unroll
            for (int i = 0; i < 16; ++i) { const int l = i ^ j; if (l > i) { const bool up = ((i & k) == 0); const unsigned hi = max(v[i], v[l]), lo = min(v[i], v[l]); v[i] = up ? hi : lo; v[l] = up ? lo : hi; } }
}
__device__ __forceinline__ void bmerge16(unsigned (&a)[16], const unsigned (&b)[16]) {
#pragma unroll
    for (int i = 0; i < 16; ++i) a[i] = max(a[i], b[15 - i]);
#pragma unroll
    for (int j = 8; j > 0; j >>= 1)
#pragma unroll
        for (int i = 0; i < 16; ++i) { const int l = i ^ j; if (l > i) { const unsigned hi = max(a[i], a[l]), lo = min(a[i], a[l]); a[i] = hi; a[l] = lo; } }
}
__device__ __forceinline__ unsigned f2ord(float s) { const unsigned u = __float_as_uint(s); return (u & 0x80000000u) ? ~u : (u | 0x80000000u); }
__device__ __forceinline__ void peer_topk(const Params& p, LAS unsigned char* lds, int layer, const SSRef ssin) {
    const int tid = threadIdx.x, lane = tid & 63, w = tid >> 6, fr = lane & 15, g = lane >> 4;
    const bf16_t* QP = (const bf16_t*)(p.ws + WS_QK); int* EIDX = (int*)(p.ws + WS_EIDX); float* GW = (float*)(p.ws + WS_GW);
    LAS float* SC = (LAS float*)lds;
    LAS float* TV = SC + 4 * 128 * 65;
    LAS unsigned char* TI = (LAS unsigned char*)(TV + 4 * 16 * 64);
    for (int item = blockIdx.x; item < 1024; item += gridDim.x) {
        const int hp = item & 3, t0 = (item >> 2) * 64;
        { const int hs = w >> 2, half = (w >> 1) & 1, nt0 = 4 * (w & 1), h = hp * 2 + hs;
          const bf16_t* KB = (const bf16_t*)(p.ws + (half ? WS_K2 : WS_K1)) + (size_t)(layer * 8 + h) * 128 * 128;
          f32x4 acc[4][4];
#pragma unroll
          for (int u = 0; u < 4; ++u)
#pragma unroll
              for (int tt = 0; tt < 4; ++tt) acc[u][tt] = (f32x4){0.f, 0.f, 0.f, 0.f};
#pragma unroll
          for (int ks = 0; ks < 4; ++ks) {
              bf16x8 a[4], bq[4];
#pragma unroll
              for (int u = 0; u < 4; ++u) a[u] = *(const bf16x8*)(KB + ((nt0 + u) * 16 + fr) * 128 + ks * 32 + g * 8);
#pragma unroll
              for (int tt = 0; tt < 4; ++tt) bq[tt] = *(const bf16x8*)(QP + (size_t)(t0 + tt * 16 + fr) * 2048 + h * 256 + half * 128 + ks * 32 + g * 8);
#pragma unroll
              for (int u = 0; u < 4; ++u)
#pragma unroll
                  for (int tt = 0; tt < 4; ++tt) acc[u][tt] = mfma16(a[u], bq[tt], acc[u][tt]);
          }
#pragma unroll
          for (int u = 0; u < 4; ++u)
#pragma unroll
              for (int tt = 0; tt < 4; ++tt)
#pragma unroll
                  for (int i = 0; i < 4; ++i) SC[((hs * 2 + half) * 128 + (nt0 + u) * 16 + g * 4 + i) * 65 + tt * 16 + fr] = acc[u][tt][i];
        }
        BLOCK_SYNC();
        if (tid < 256) {
            const int t = tid & 63, lh = tid >> 6;
            unsigned L[16];
#pragma unroll
            for (int i = 0; i < 16; ++i) L[i] = (f2ord(SC[(lh * 128 + i) * 65 + t]) & ~0x7Fu) | (unsigned)(127 - i);
            bsort16(L);
            for (int gi = 1; gi < 8; ++gi) {
                unsigned B[16];
#pragma unroll
                for (int i = 0; i < 16; ++i) { const int n = gi * 16 + i; B[i] = (f2ord(SC[(lh * 128 + n) * 65 + t]) & ~0x7Fu) | (unsigned)(127 - n); }
                bsort16(B); bmerge16(L, B);
            }
#pragma unroll
            for (int i = 0; i < 16; ++i) { const int n = 127 - (int)(L[i] & 0x7Fu); TV[(lh * 16 + i) * 64 + t] = SC[(lh * 128 + n) * 65 + t]; TI[(lh * 16 + i) * 64 + t] = (unsigned char)n; }
        }
        BLOCK_SYNC();
        if (tid < 128) {
            const int t = tid & 63, hs = tid >> 6, h = hp * 2 + hs;
            const LAS float* TV1 = TV + (hs * 2) * 16 * 64; const LAS float* TV2 = TV1 + 16 * 64;
            const LAS unsigned char* TI1 = TI + (hs * 2) * 16 * 64; const LAS unsigned char* TI2 = TI1 + 16 * 64;
            float v2[16];
#pragma unroll
            for (int bq = 0; bq < 16; ++bq) v2[bq] = TV2[bq * 64 + t];
            float v1[16];
#pragma unroll
            for (int a = 0; a < 16; ++a) v1[a] = TV1[a * 64 + t];
            unsigned C[4][16];
            { int cnt = 0;
#pragma unroll
              for (int a = 0; a < 16; ++a)
#pragma unroll
                  for (int bq = 0; bq < 16; ++bq) if ((a + 1) * (bq + 1) <= 16) { C[cnt >> 4][cnt & 15] = (f2ord(v1[a] + v2[bq]) & ~0xFFu) | (unsigned)(255 - (a * 16 + bq)); ++cnt; }
#pragma unroll
              for (int c2 = 50; c2 < 64; ++c2) C[c2 >> 4][c2 & 15] = 0u; }
            bsort16(C[0]); bsort16(C[1]); bsort16(C[2]); bsort16(C[3]);
            bmerge16(C[0], C[1]); bmerge16(C[2], C[3]); bmerge16(C[0], C[2]);
            unsigned (&L)[16] = C[0];
            float sv[16]; int e[16]; float mx = -INFINITY;
#pragma unroll
            for (int i = 0; i < 16; ++i) { const int flat = 255 - (int)(L[i] & 0xFFu), a = flat >> 4, bq = flat & 15;
                sv[i] = TV1[a * 64 + t] + TV2[bq * 64 + t]; e[i] = (int)TI1[a * 64 + t] * 128 + (int)TI2[bq * 64 + t]; mx = fmaxf(mx, sv[i]); }
            float sum = 0.f;
#pragma unroll
            for (int i = 0; i < 16; ++i) { sv[i] = __expf(sv[i] - mx); sum += sv[i]; }
            const float inv = 1.0f / sum;
#pragma unroll
            for (int i = 0; i < 16; i += 4) {
#pragma unroll
                for (int k2 = 0; k2 < 4; ++k2) { const int sl_ = h * 16 + i + k2; EIDX[(size_t)(t0 + t) * 128 + (sl_ & 7) * 16 + (sl_ >> 3)] = e[i + k2]; }
                *(f32x4*)(GW + (size_t)(t0 + t) * 128 + h * 16 + i) = (f32x4){sv[i] * inv, sv[i + 1] * inv, sv[i + 2] * inv, sv[i + 3] * inv};
            }
        }
        BLOCK_SYNC();
    }
}

typedef _Float16 h16x2 __attribute__((ext_vector_type(2)));
#define U8H_LO(w) __builtin_bit_cast(h16x2, __builtin_amdgcn_perm(0x64646464u, (unsigned)(w), 0x04010400u))
#define U8H_HI(w) __builtin_bit_cast(h16x2, __builtin_amdgcn_perm(0x64646464u, (unsigned)(w), 0x04030402u))
__device__ __forceinline__ float dot16_fp8(const u32x4 r, const h16x2* x) {
    float a = __builtin_amdgcn_fdot2(U8H_LO(r.x), x[0], 0.f, false); a = __builtin_amdgcn_fdot2(U8H_HI(r.x), x[1], a, false);
    a = __builtin_amdgcn_fdot2(U8H_LO(r.y), x[2], a, false); a = __builtin_amdgcn_fdot2(U8H_HI(r.y), x[3], a, false);
    a = __builtin_amdgcn_fdot2(U8H_LO(r.z), x[4], a, false); a = __builtin_amdgcn_fdot2(U8H_HI(r.z), x[5], a, false);
    a = __builtin_amdgcn_fdot2(U8H_LO(r.w), x[6], a, false); a = __builtin_amdgcn_fdot2(U8H_HI(r.w), x[7], a, false);
    return a;
}
__device__ __forceinline__ void axpy16_fp8(const u32x4 r, const h16x2 cf, h16x2* y) {
    const h16x2 off = (h16x2){(_Float16)(-1152.0f), (_Float16)(-1152.0f)};
    y[0] += (U8H_LO(r.x) + off) * cf; y[1] += (U8H_HI(r.x) + off) * cf; y[2] += (U8H_LO(r.y) + off) * cf; y[3] += (U8H_HI(r.y) + off) * cf;
    y[4] += (U8H_LO(r.z) + off) * cf; y[5] += (U8H_HI(r.z) + off) * cf; y[6] += (U8H_LO(r.w) + off) * cf; y[7] += (U8H_HI(r.w) + off) * cf;
}
template <int B0> __device__ __forceinline__ void treduce16(const float (&v)[16], const int lane, float& out0, float& out1) {
    const bool s0 = lane & B0, s1 = lane & (2 * B0), s2 = lane & (4 * B0);
    float w[8], x[4];
#pragma unroll
    for (int k = 0; k < 8; ++k) { const float keep = s0 ? v[2 * k + 1] : v[2 * k], give = s0 ? v[2 * k] : v[2 * k + 1]; w[k] = keep + __shfl_xor(give, B0); }
#pragma unroll
    for (int k = 0; k < 4; ++k) { const float keep = s1 ? w[2 * k + 1] : w[2 * k], give = s1 ? w[2 * k] : w[2 * k + 1]; x[k] = keep + __shfl_xor(give, 2 * B0); }
    { const float keep = s2 ? x[1] : x[0], give = s2 ? x[0] : x[1]; out0 = keep + __shfl_xor(give, 4 * B0); }
    { const float keep = s2 ? x[3] : x[2], give = s2 ? x[2] : x[3]; out1 = keep + __shfl_xor(give, 4 * B0); }
}
struct PeerMap { int xcd, wv, nwv; };
__device__ __forceinline__ PeerMap peer_map() { PeerMap m; m.xcd = blockIdx.x & 7; m.wv = (blockIdx.x >> 3) * 8 + (threadIdx.x >> 6); m.nwv = (((int)gridDim.x - m.xcd + 7) >> 3) * 8; return m; }

__device__ __forceinline__ void peer_xquant(const Params& p, int layer, const SSRef ssin, const bf16_t* HBin) {
    const int lane = threadIdx.x & 63, gw = blockIdx.x * 8 + (threadIdx.x >> 6), NGW = gridDim.x * 8;
    const float* cn = p.in[13] + layer * D;
    unsigned* XQ = (unsigned*)(p.ws + WS_XQ); float* XS = (float*)(p.ws + WS_XS);
    for (int t = gw; t < T; t += NGW) {
        const float rs = rstd_of(ss_get(ssin, t));
        f32x4 x[8];
#pragma unroll
        for (int k = 0; k < 8; ++k) { const u32x2 hb = *(const u32x2*)(HBin + (size_t)t * D + k * 256 + lane * 4); x[k] = (f32x4){bflo(hb.x), bfhi(hb.x), bflo(hb.y), bfhi(hb.y)} * rs * *(const f32x4*)(cn + k * 256 + lane * 4); }
#pragma unroll
        for (int k = 0; k < 8; ++k) {
            float am = fmaxf(fmaxf(fabsf(x[k][0]), fabsf(x[k][1])), fmaxf(fabsf(x[k][2]), fabsf(x[k][3])));
            am = fmaxf(am, __shfl_xor(am, 1)); am = fmaxf(am, __shfl_xor(am, 2));
            const float sc = am > 0.f ? 127.0f / am : 0.f;
            const unsigned q0 = (unsigned)(int)rintf(x[k][0] * sc) & 255u, q1 = (unsigned)(int)rintf(x[k][1] * sc) & 255u, q2 = (unsigned)(int)rintf(x[k][2] * sc) & 255u, q3 = (unsigned)(int)rintf(x[k][3] * sc) & 255u;
            XQ[(size_t)t * 512 + k * 64 + lane] = q0 | (q1 << 8) | (q2 << 16) | (q3 << 24);
            if ((lane & 3) == 0) XS[(size_t)t * 128 + k * 16 + (lane >> 2)] = am * (1.0f / 127.0f);
        }
    }
}
__device__ __forceinline__ float dot16_i8(const u32x4 r, const u32x4 x) {
    int a = __builtin_amdgcn_sdot4((int)r.x, (int)x.x, 0, false); a = __builtin_amdgcn_sdot4((int)r.y, (int)x.y, a, false);
    a = __builtin_amdgcn_sdot4((int)r.z, (int)x.z, a, false); a = __builtin_amdgcn_sdot4((int)r.w, (int)x.w, a, false);
    return (float)a;
}
__device__ __forceinline__ void peer_upass(const Params& p, int layer) {
    const int lane = threadIdx.x & 63, q = lane >> 3, c = lane & 7; const PeerMap pm = peer_map();
    const int* EIDX = (const int*)(p.ws + WS_EIDX); _Float16* PA = (_Float16*)(p.ws + WS_PA);
    const unsigned char* XQ = p.ws + WS_XQ; const float* XS = (const float*)(p.ws + WS_XS);
    for (int r = 0; r < 2; ++r) {
        const int sl = pm.xcd + 8 * r;
        const unsigned char* U8 = p.ws + WS_UB + (size_t)(layer * 16 + sl) * 16384 * 128; const unsigned c16 = c * 16;
        int idx[16], idxn[16]; u32x4 rowsA[8], rowsB[8]; u32x4 xq = (u32x4){0u, 0u, 0u, 0u}, xqn = xq; float xs = 0.f, xsn = 0.f;
        if (pm.wv < T) {
#pragma unroll
            for (int i = 0; i < 4; ++i) { const int4 e4 = *(const int4*)(EIDX + (size_t)pm.wv * 128 + q * 16 + 4 * i); idx[4 * i] = e4.x; idx[4 * i + 1] = e4.y; idx[4 * i + 2] = e4.z; idx[4 * i + 3] = e4.w; }
            xq = *(const u32x4*)(XQ + (size_t)pm.wv * D + sl * 128 + c16); xs = XS[(size_t)pm.wv * 128 + sl * 8 + c];
#pragma unroll
            for (int i = 0; i < 8; ++i) rowsA[i] = *(const u32x4*)(U8 + (((unsigned)idx[i] << 7) | c16));
        }
        for (int t = pm.wv; t < T; t += pm.nwv) {
#pragma unroll
            for (int i = 0; i < 8; ++i) rowsB[i] = *(const u32x4*)(U8 + (((unsigned)idx[8 + i] << 7) | c16));
            const int tn = t + pm.nwv; const bool nv = tn < T;
            if (nv) {
#pragma unroll
                for (int i = 0; i < 4; ++i) { const int4 e4 = *(const int4*)(EIDX + (size_t)tn * 128 + q * 16 + 4 * i); idxn[4 * i] = e4.x; idxn[4 * i + 1] = e4.y; idxn[4 * i + 2] = e4.z; idxn[4 * i + 3] = e4.w; }
                xqn = *(const u32x4*)(XQ + (size_t)tn * D + sl * 128 + c16); xsn = XS[(size_t)tn * 128 + sl * 8 + c];
            }
            float v[16];
#pragma unroll
            for (int i = 0; i < 8; ++i) v[i] = dot16_i8(rowsA[i], xq) * xs;
            if (nv) {
#pragma unroll
                for (int i = 0; i < 8; ++i) rowsA[i] = *(const u32x4*)(U8 + (((unsigned)idxn[i] << 7) | c16));
            }
#pragma unroll
            for (int i = 0; i < 8; ++i) v[8 + i] = dot16_i8(rowsB[i], xq) * xs;
            float z0, z1; treduce16<1>(v, lane, z0, z1);
            _Float16* pa = PA + ((size_t)t * 16 + sl) * 128 + 8 * c + q;
            pa[0] = (_Float16)z0; pa[64] = (_Float16)z1;
#pragma unroll
            for (int i = 0; i < 16; ++i) idx[i] = idxn[i];
            xq = xqn; xs = xsn;
        }
    }
}
__device__ __forceinline__ void peer_combine(const Params& p, int layer) {
    const int lane = threadIdx.x & 63, gw = blockIdx.x * 8 + (threadIdx.x >> 6), NGW = gridDim.x * 8;
    const int* EIDX = (const int*)(p.ws + WS_EIDX); const float* GW = (const float*)(p.ws + WS_GW); const _Float16* PA = (const _Float16*)(p.ws + WS_PA);
    const float* USC = (const float*)(p.ws + WS_USC) + layer * 16384; const float* VSC = (const float*)(p.ws + WS_VSC) + layer * 16384;
    int2* CI = (int2*)(p.ws + WS_CI);
    for (int t = gw; t < T; t += NGW) {
        float a_lo = 0.f, a_hi = 0.f;
#pragma unroll
        for (int s2 = 0; s2 < 16; ++s2) { a_lo += (float)PA[((size_t)t * 16 + s2) * 128 + lane]; a_hi += (float)PA[((size_t)t * 16 + s2) * 128 + 64 + lane]; }
        const int e_lo = EIDX[(size_t)t * 128 + (lane & 7) * 16 + (lane >> 3)], e_hi = EIDX[(size_t)t * 128 + (lane & 7) * 16 + 8 + (lane >> 3)];
        a_lo *= USC[e_lo]; a_hi *= USC[e_hi];
        const float c_lo = GW[(size_t)t * 128 + lane] * 0.5f * a_lo * (1.0f + erff(a_lo * 0.70710678118f)) * VSC[e_lo];
        const float c_hi = GW[(size_t)t * 128 + 64 + lane] * 0.5f * a_hi * (1.0f + erff(a_hi * 0.70710678118f)) * VSC[e_hi];
        float mx = fmaxf(fabsf(c_lo), fabsf(c_hi));
#pragma unroll
        for (int o = 1; o < 64; o <<= 1) mx = fmaxf(mx, __shfl_xor(mx, o));
        const float qs = mx > 0.f ? 127.0f / mx : 0.f, tsc = mx * (1.0f / 127.0f);
        const int kb = 8 * ((lane >> 3) & 3);
        unsigned w_lo = ((unsigned)(int)rintf(c_lo * qs) & 255u) << kb, w_hi = ((unsigned)(int)rintf(c_hi * qs) & 255u) << kb;
        w_lo |= __shfl_xor(w_lo, 8); w_lo |= __shfl_xor(w_lo, 16); w_hi |= __shfl_xor(w_hi, 8); w_hi |= __shfl_xor(w_hi, 16);
        if (((lane >> 3) & 3) == 0) { unsigned* CFQ = (unsigned*)CI; CFQ[(size_t)t * 32 + (lane >> 5) * 8 + (lane & 7)] = w_lo; CFQ[(size_t)t * 32 + (2 + (lane >> 5)) * 8 + (lane & 7)] = w_hi; }
        if (lane == 0) ((float*)(p.ws + WS_SS) + 6 * T)[t] = tsc;
    }
}
__device__ __forceinline__ void vgrp4(const unsigned a, const unsigned b, const unsigned c, const unsigned d, const int cw, int* acc) {
    const unsigned ab_lo = __builtin_amdgcn_perm(b, a, 0x05010400u), ab_hi = __builtin_amdgcn_perm(b, a, 0x07030602u);
    const unsigned cd_lo = __builtin_amdgcn_perm(d, c, 0x05010400u), cd_hi = __builtin_amdgcn_perm(d, c, 0x07030602u);
    acc[0] = __builtin_amdgcn_sdot4((int)__builtin_amdgcn_perm(cd_lo, ab_lo, 0x05040100u), cw, acc[0], false);
    acc[1] = __builtin_amdgcn_sdot4((int)__builtin_amdgcn_perm(cd_lo, ab_lo, 0x07060302u), cw, acc[1], false);
    acc[2] = __builtin_amdgcn_sdot4((int)__builtin_amdgcn_perm(cd_hi, ab_hi, 0x05040100u), cw, acc[2], false);
    acc[3] = __builtin_amdgcn_sdot4((int)__builtin_amdgcn_perm(cd_hi, ab_hi, 0x07060302u), cw, acc[3], false);
}
__device__ __forceinline__ void vrows4(const u32x4 a, const u32x4 b, const u32x4 c, const u32x4 d, const int cw, int* acc) {
    vgrp4(a.x, b.x, c.x, d.x, cw, acc); vgrp4(a.y, b.y, c.y, d.y, cw, acc + 4); vgrp4(a.z, b.z, c.z, d.z, cw, acc + 8); vgrp4(a.w, b.w, c.w, d.w, cw, acc + 12);
}
__device__ __forceinline__ void peer_vpass(const Params& p, int layer, float* SSQ, const bf16_t* HBin, bf16_t* HBout) {
    const int lane = threadIdx.x & 63, q = lane >> 3, c = lane & 7; const PeerMap pm = peer_map();
    const int* EIDX = (const int*)(p.ws + WS_EIDX); const int* CFQ = (const int*)(p.ws + WS_CI); const float* TSC = (const float*)(p.ws + WS_SS) + 6 * T;
    for (int r = 0; r < 2; ++r) {
        const int sl = pm.xcd + 8 * r;
        const unsigned char* V8 = p.ws + WS_VB + (size_t)(layer * 16 + sl) * 16384 * 128; const unsigned c16 = c * 16;
        int idx[16], idxn[16], cw[4], cwn[4]; u32x4 rowsA[8], rowsB[8];
        if (pm.wv < T) {
#pragma unroll
            for (int i = 0; i < 4; ++i) { const int4 e4 = *(const int4*)(EIDX + (size_t)pm.wv * 128 + q * 16 + 4 * i); idx[4 * i] = e4.x; idx[4 * i + 1] = e4.y; idx[4 * i + 2] = e4.z; idx[4 * i + 3] = e4.w; }
#pragma unroll
            for (int j = 0; j < 4; ++j) cw[j] = CFQ[(size_t)pm.wv * 32 + j * 8 + q];
#pragma unroll
            for (int i = 0; i < 8; ++i) rowsA[i] = *(const u32x4*)(V8 + (((unsigned)idx[i] << 7) | c16));
        }
        for (int t = pm.wv; t < T; t += pm.nwv) {
#pragma unroll
            for (int i = 0; i < 8; ++i) rowsB[i] = *(const u32x4*)(V8 + (((unsigned)idx[8 + i] << 7) | c16));
            const size_t off = (size_t)t * D + sl * 128 + c * 16 + q;
            const float h0 = __uint_as_float((unsigned)HBin[off] << 16), h1 = __uint_as_float((unsigned)HBin[off + 8] << 16), tsc = TSC[t];
            const int tn = t + pm.nwv; const bool nv = tn < T;
            if (nv) {
#pragma unroll
                for (int i = 0; i < 4; ++i) { const int4 e4 = *(const int4*)(EIDX + (size_t)tn * 128 + q * 16 + 4 * i); idxn[4 * i] = e4.x; idxn[4 * i + 1] = e4.y; idxn[4 * i + 2] = e4.z; idxn[4 * i + 3] = e4.w; }
#pragma unroll
                for (int j = 0; j < 4; ++j) cwn[j] = CFQ[(size_t)tn * 32 + j * 8 + q];
            }
            int acc[16];
#pragma unroll
            for (int k = 0; k < 16; ++k) acc[k] = 0;
            vrows4(rowsA[0], rowsA[1], rowsA[2], rowsA[3], cw[0], acc); vrows4(rowsA[4], rowsA[5], rowsA[6], rowsA[7], cw[1], acc);
            if (nv) {
#pragma unroll
                for (int i = 0; i < 8; ++i) rowsA[i] = *(const u32x4*)(V8 + (((unsigned)idxn[i] << 7) | c16));
            }
            vrows4(rowsB[0], rowsB[1], rowsB[2], rowsB[3], cw[2], acc); vrows4(rowsB[4], rowsB[5], rowsB[6], rowsB[7], cw[3], acc);
            float v[16];
#pragma unroll
            for (int k = 0; k < 16; ++k) v[k] = (float)acc[k];
            float z0, z1; treduce16<8>(v, lane, z0, z1);
            const float o0 = h0 + z0 * tsc, o1 = h1 + z1 * tsc;
            HBout[off] = (bf16_t)(pk2(o0, 0.f) & 0xffffu); HBout[off + 8] = (bf16_t)(pk2(o1, 0.f) & 0xffffu);
            const float ss = wave_sum(o0 * o0 + o1 * o1);
            if (lane == 0) SSQ[(size_t)t * 16 + sl] = ss;
#pragma unroll
            for (int i = 0; i < 16; ++i) idx[i] = idxn[i];
#pragma unroll
            for (int j = 0; j < 4; ++j) cw[j] = cwn[j];
        }
    }
}

__device__ __forceinline__ void swa_phase(const Params& p, LAS unsigned char* lds) {
    const int tid = threadIdx.x, lane = tid & 63, w = tid >> 6, fr = lane & 15, g = lane >> 4;
    const bf16_t* QK2 = (const bf16_t*)(p.ws + WS_QK2); const bf16_t* VT2 = (const bf16_t*)(p.ws + WS_VT2); bf16_t* O = (bf16_t*)(p.ws + WS_O);
    LAS unsigned char* Ks = lds; LAS unsigned char* VTs = lds + 27648;
    u32x4 pk[3], pv[3];
#define SWA_ISSUE(it_) do { const int i_ = (it_); const int t0_ = (i_ & 127) * 64, kvh_ = (i_ >> 7) & 3, b_ = i_ >> 9; \
        _Pragma("unroll") for (int j = 0; j < 3; ++j) { const int q = tid + 512 * j; \
            { const int row = q >> 3, cc = q & 7; int tk = t0_ - 128 + row; tk = tk < 0 ? 0 : tk; pk[j] = *(const u32x4*)(QK2 + ((size_t)b_ * SEQ + tk) * 2304 + 2048 + kvh_ * 64 + cc * 8); } \
            { const int d = q / 24, cc = q % 24; const int tk = t0_ - 128 + cc * 8; pv[j] = (u32x4){0u, 0u, 0u, 0u}; if (tk >= 0) pv[j] = *(const u32x4*)(VT2 + (size_t)(kvh_ * 64 + d) * T + (size_t)b_ * SEQ + tk); } } } while (0)
    if ((int)blockIdx.x < 1024) SWA_ISSUE(blockIdx.x);
    for (int item = blockIdx.x; item < 1024; item += gridDim.x) {
        const int t0 = (item & 127) * 64, kvh = (item >> 7) & 3, b = item >> 9;
#pragma unroll
        for (int j = 0; j < 3; ++j) { const int q = tid + 512 * j; *(LAS u32x4*)(Ks + (q >> 3) * 144 + (q & 7) * 16) = pk[j]; *(LAS u32x4*)(VTs + (q / 24) * 400 + (q % 24) * 16) = pv[j]; }
        if (item + (int)gridDim.x < 1024) SWA_ISSUE(item + (int)gridDim.x);
        asm volatile("s_waitcnt lgkmcnt(0)" ::: "memory"); __builtin_amdgcn_s_barrier(); asm volatile("" ::: "memory");
        const int qh = kvh * 8 + w; const float sink = p.in[11][qh];
        for (int u = 0; u < 2; ++u) {
            const int t0u = t0 + 32 * u; const LAS unsigned char* Ku = Ks + 32 * u * 144; const LAS unsigned char* Vu = VTs + 64 * u;
            bf16x8 bq[2][2];
#pragma unroll
            for (int tt = 0; tt < 2; ++tt)
#pragma unroll
                for (int ks = 0; ks < 2; ++ks) bq[tt][ks] = *(const bf16x8*)(QK2 + ((size_t)b * SEQ + t0u + tt * 16 + fr) * 2304 + qh * 64 + ks * 32 + g * 8);
            f32x4 s[10][2];
#pragma unroll
            for (int kt = 0; kt < 10; ++kt) {
                s[kt][0] = (f32x4){0.f, 0.f, 0.f, 0.f}; s[kt][1] = (f32x4){0.f, 0.f, 0.f, 0.f};
#pragma unroll
                for (int ks = 0; ks < 2; ++ks) { const bf16x8 a = lfrag(Ku, kt * 16 + fr, 144, ks * 64 + g * 16);
                    s[kt][0] = mfma16(a, bq[0][ks], s[kt][0]); s[kt][1] = mfma16(a, bq[1][ks], s[kt][1]); }
            }
            float den[2];
#pragma unroll
            for (int tt = 0; tt < 2; ++tt) { const int t = tt * 16 + fr; float mx = sink;
#pragma unroll
                for (int kt = 0; kt < 10; ++kt)
#pragma unroll
                    for (int i = 0; i < 4; ++i) { const int kk = kt * 16 + g * 4 + i; const bool valid = (kk > t) && (kk <= t + 128) && (t0u - 128 + kk >= 0);
                        s[kt][tt][i] = valid ? s[kt][tt][i] : -INFINITY; mx = fmaxf(mx, s[kt][tt][i]); }
                mx = fmaxf(mx, __shfl_xor(mx, 16)); mx = fmaxf(mx, __shfl_xor(mx, 32));
                float sum = 0.f;
#pragma unroll
                for (int kt = 0; kt < 10; ++kt)
#pragma unroll
                    for (int i = 0; i < 4; ++i) { const float pr = __expf(s[kt][tt][i] - mx); s[kt][tt][i] = pr; sum += pr; }
                sum += __shfl_xor(sum, 16); sum += __shfl_xor(sum, 32);
                den[tt] = sum + __expf(sink - mx); }
            f32x4 o[4][2];
#pragma unroll
            for (int dt = 0; dt < 4; ++dt) { o[dt][0] = (f32x4){0.f, 0.f, 0.f, 0.f}; o[dt][1] = (f32x4){0.f, 0.f, 0.f, 0.f}; }
#pragma unroll
            for (int sx = 0; sx < 5; ++sx) {
                bf16x8 bp[2];
#pragma unroll
                for (int tt = 0; tt < 2; ++tt) { const u32x4 pkd = (u32x4){pk2(s[2 * sx][tt][0], s[2 * sx][tt][1]), pk2(s[2 * sx][tt][2], s[2 * sx][tt][3]), pk2(s[2 * sx + 1][tt][0], s[2 * sx + 1][tt][1]), pk2(s[2 * sx + 1][tt][2], s[2 * sx + 1][tt][3])};
                    bp[tt] = __builtin_bit_cast(bf16x8, pkd); }
#pragma unroll
                for (int dt = 0; dt < 4; ++dt) {
                    const u32x2 lo = *(const LAS u32x2*)(Vu + (dt * 16 + fr) * 400 + ((2 * sx) * 16 + g * 4) * 2), hi = *(const LAS u32x2*)(Vu + (dt * 16 + fr) * 400 + ((2 * sx + 1) * 16 + g * 4) * 2);
                    const bf16x8 a = __builtin_bit_cast(bf16x8, (u32x4){lo.x, lo.y, hi.x, hi.y});
                    o[dt][0] = mfma16(a, bp[0], o[dt][0]); o[dt][1] = mfma16(a, bp[1], o[dt][1]);
                }
            }
#pragma unroll
            for (int tt = 0; tt < 2; ++tt) { const float inv = 1.0f / den[tt];
#pragma unroll
                for (int dt = 0; dt < 4; ++dt)
                    *(u32x2*)(O + ((size_t)b * SEQ + t0u + tt * 16 + fr) * 2048 + qh * 64 + dt * 16 + g * 4) = (u32x2){pk2(o[dt][tt][0] * inv, o[dt][tt][1] * inv), pk2(o[dt][tt][2] * inv, o[dt][tt][3] * inv)}; }
        }
        asm volatile("s_waitcnt lgkmcnt(0)" ::: "memory"); __builtin_amdgcn_s_barrier(); asm volatile("" ::: "memory");
    }
#undef SWA_ISSUE
}

__device__ __forceinline__ void final_phase(const Params& p, const bf16_t* HBin) {
    const int lane = threadIdx.x & 63, gw = blockIdx.x * 8 + (threadIdx.x >> 6), NGW = gridDim.x * 8;
    const SSRef ss{(const float*)(p.ws + WS_SSP) + (size_t)3 * T * 32, 32}; const float* fn = p.in[22];
    for (int m = gw; m < T; m += NGW) { const float rs = rstd_of(ss_get(ss, m));
#pragma unroll
        for (int j = 0; j < 4; ++j) { const size_t off = (size_t)m * D + j * 512 + lane * 8; const u32x4 hb = *(const u32x4*)(HBin + off);
            const f32x4 n0 = *(const f32x4*)(fn + j * 512 + lane * 8), n1 = *(const f32x4*)(fn + j * 512 + lane * 8 + 4);
            *(f32x4*)(p.out + off) = (f32x4){bflo(hb.x), bfhi(hb.x), bflo(hb.y), bfhi(hb.y)} * rs * n0;
            *(f32x4*)(p.out + off + 4) = (f32x4){bflo(hb.z), bfhi(hb.z), bflo(hb.w), bfhi(hb.w)} * rs * n1; } }
}

#define RLX_AGENT __ATOMIC_RELAXED, __HIP_MEMORY_SCOPE_AGENT
#define XB_TMO      128
#define XB_XCNT(j)  (256  + 64 * (j))
#define XB_XSUB(j)  (1280 + 64 * (j))
#define XB_XGEN(j)  (2304 + 64 * (j))
#define XB_TOP      3328
#define XB_TOPGEN   3392
#define XCD_BAR_WORDS 3456
#define XB_SPIN_CAP (1u << 18)

__device__ __forceinline__ unsigned xb_ld(unsigned* p)              { return __hip_atomic_load(p, __ATOMIC_RELAXED, __HIP_MEMORY_SCOPE_AGENT); }
__device__ __forceinline__ unsigned xb_add(unsigned* p, unsigned v) { return __hip_atomic_fetch_add(p, v, __ATOMIC_RELAXED, __HIP_MEMORY_SCOPE_AGENT); }
__device__ __forceinline__ unsigned xb_xcc_id() { return (unsigned)__builtin_amdgcn_s_getreg((3 << 11) | 20) & 0xFu; }
#define XB_SPIN(cond, bar) do { unsigned _sp = 0; while (cond) { __builtin_amdgcn_s_sleep(1); \
    if ((++_sp & 255u) == 0u) { if (xb_ld(&(bar)[XB_TMO])) break; if (_sp > XB_SPIN_CAP) { atomicAdd(&(bar)[XB_TMO], 1u); break; } } } } while (0)

struct XcdBarrier {
    unsigned* bar; unsigned x;
    volatile LAS unsigned* st;
};

__device__ __forceinline__ XcdBarrier xcd_barrier_post(unsigned* bar, volatile LAS unsigned* st) {
    XcdBarrier b; b.bar = bar; b.x = xb_xcc_id(); b.st = st;
    if (threadIdx.x == 0) (void)xb_add(&bar[XB_XCNT(b.x)], 1u);
    return b;
}
__device__ __forceinline__ void xcd_barrier_complete(unsigned* bar, unsigned x, unsigned& nloc, unsigned& nx) {
    const unsigned G = gridDim.x * gridDim.y * gridDim.z;
    unsigned sum, cnt, mine, sp = 0u;
    for (;;) {
        sum = 0u; cnt = 0u; mine = 0u;
#pragma unroll
        for (unsigned j = 0; j < 16; ++j) { const unsigned c = xb_ld(&bar[XB_XCNT(j)]); sum += c; cnt += (c > 0u) ? 1u : 0u; mine = (j == x) ? c : mine; }
        if (sum == G) break;
        __builtin_amdgcn_s_sleep(1);
        if ((++sp & 255u) == 0u) { if (xb_ld(&bar[XB_TMO])) break; if (sp > XB_SPIN_CAP) { atomicAdd(&bar[XB_TMO], 1u); break; } }
    }
    nloc = mine > 0u ? mine : 1u; nx = cnt > 0u ? cnt : 1u;
}

__device__ __forceinline__ void xcd_barrier(const XcdBarrier& b) {
    asm volatile("s_waitcnt vmcnt(0)" ::: "memory");
    __syncthreads();
    if (threadIdx.x == 0) {
        unsigned* bar = b.bar;
        __builtin_amdgcn_s_waitcnt(0);
        unsigned nloc = b.st[0], nx = b.st[1];
        if (nloc == 0u) { xcd_barrier_complete(bar, b.x, nloc, nx); b.st[0] = nloc; b.st[1] = nx; }
        const unsigned old = xb_add(&bar[XB_XSUB(b.x)], 1u);
        const unsigned gen = old / nloc;
        if (old + 1u == (gen + 1u) * nloc) {
            __builtin_amdgcn_fence(__ATOMIC_RELEASE, "agent");
            asm volatile("s_waitcnt vmcnt(0)" ::: "memory");
            const unsigned og = xb_add(&bar[XB_TOP], 1u);
            const unsigned tg = og / nx;
            if (og + 1u == (tg + 1u) * nx) xb_add(&bar[XB_TOPGEN], 1u);
            else XB_SPIN(xb_ld(&bar[XB_TOPGEN]) == tg, bar);
            __builtin_amdgcn_fence(__ATOMIC_ACQUIRE, "agent");
            xb_add(&bar[XB_XGEN(b.x)], 1u);
            asm volatile("s_waitcnt vmcnt(0)" ::: "memory");
        } else {
            XB_SPIN(xb_ld(&bar[XB_XGEN(b.x)]) == gen, bar);
            __builtin_amdgcn_fence(__ATOMIC_ACQUIRE, "agent");
            asm volatile("s_waitcnt vmcnt(0)" ::: "memory");
        }
    }
    __syncthreads();
}
__global__ void __launch_bounds__(512, 2) yoco_fwd(Params p) {
    extern __shared__ __attribute__((aligned(16))) unsigned char lds_raw[];
    LAS unsigned char* lds = (LAS unsigned char*)lds_raw;
    cg::grid_group grid = cg::this_grid();
    volatile LAS unsigned* bst = (volatile LAS unsigned*)(lds + (LDS_BYTES - 16));
    if (threadIdx.x < 4) bst[threadIdx.x] = 0u;
    __syncthreads();
    const XcdBarrier xbar = xcd_barrier_post((unsigned*)(p.ws + WS_BAR), bst);
    unsigned char* ws = p.ws;
    float* SS = (float*)(ws + WS_SS);
    bf16_t* HBA = (bf16_t*)(ws + WS_HBA); bf16_t* HBB = (bf16_t*)(ws + WS_HBB);
    const int lo = p.ph_lo, hi = p.ph_hi;
#define IN(k) (lo <= (k) && (k) < hi)
#define SEAM(k) do { if (IN(k) && IN((k) + 1)) xcd_barrier(xbar); } while (0)
    float* SSP = (float*)(ws + WS_SSP);
    float* SSQ = (float*)(ws + WS_SSQ);
    const SSRef ss0{SS, 1}, ss2{SSQ, 16}, ss5{SSQ + (size_t)T * 16, 16}, ssN{nullptr, 1};
    const SSRef ss1{SSP, 32}, ss3{SSP + (size_t)1 * T * 32, 32}, ss4{SSP + (size_t)2 * T * 32, 32};
    if (p.ph_hi < 0) grid.sync();
    if (IN(0)) p0_prologue(p, lds);
    SEAM(0);
    if (IN(1)) {
        if (blockIdx.x < 8) gate_prefix(p, lds, blockIdx.x);
        { EpiScale E{(bf16_t*)(ws + WS_QK), 2048, ss0, ssN}; run_gemm(lds, HBA, (const bf16_t*)(ws + WS_WIN), T, 2048, 2048, E); }
        { EpiScale E{(bf16_t*)(ws + WS_OG), 2048, ss0, ssN}; run_gemm(lds, HBA, (const bf16_t*)(ws + WS_WIN) + (size_t)4096 * 2048, T, 2048, 2048, E); }
        { EpiScale E{(bf16_t*)(ws + WS_KVT), T, ssN, ss0}; run_gemm(lds, (const bf16_t*)(ws + WS_WIN) + (size_t)2048 * 2048, HBA, 2048, T, 2048, E); }
        { EpiScale E{(bf16_t*)(ws + WS_PP), 2048, ssN, ssN}; run_gemm(lds, (const bf16_t*)(ws + WS_PB), (const bf16_t*)(ws + WS_WPR), T, 2048, 256, E); }
    }
    SEAM(1);
    if (IN(2)) { if (NSEG > 1) for (int it = blockIdx.x; it < 8 * 8 * (NSEG - 1); it += gridDim.x) mlstm_item(p, lds, it & 7, (it >> 3) & 7, it >> 6, false);
        if (gridDim.x == 256 && blockIdx.x >= 192)
            cvt_rows_fp8(p.in[17], ws + WS_UB, (float*)(ws + WS_USC), 16384, 2 * 16384, ((int)blockIdx.x - 192) * 8 + (int)(threadIdx.x >> 6), 64 * 8, (int)(threadIdx.x & 63), 0); }
    SEAM(2);
    if (IN(3)) { for (int it = blockIdx.x; it < 8 * 8 * NSEG; it += gridDim.x) mlstm_item(p, lds, it & 7, (it >> 3) & 7, it >> 6, true); }
    SEAM(3);
    if (IN(4)) headnorm_phase(p);
    SEAM(4);
    if (IN(5)) { EpiRes<false, true> E{p.in[0], HBB, SSP, nullptr, ssN}; run_gemm(lds, (const bf16_t*)(ws + WS_QK), (const bf16_t*)(ws + WS_WOUT), T, 2048, 2048, E); }
    SEAM(5);
    if (IN(6)) { EpiScale E{(bf16_t*)(ws + WS_QK), 2048, ss1, ssN}; run_gemm(lds, HBB, (const bf16_t*)(ws + WS_WPQ), T, 2048, 2048, E); }
    SEAM(6);
    if (IN(7)) { peer_topk(p, lds, 0, ss1); peer_xquant(p, 0, ss1, HBB); }
    SEAM(7);
    if (IN(8)) { peer_upass(p, 0); xcd_barrier(xbar); peer_combine(p, 0); xcd_barrier(xbar); peer_vpass(p, 0, SSQ, HBB, HBA); }
    SEAM(8);
    if (IN(9)) { EpiRes<true, false> E{HBA, HBB, SSP + (size_t)1 * T * 32, (const bf16_t*)(ws + WS_PP), ss2}; run_gemm(lds, HBA, (const bf16_t*)(ws + WS_WG), T, 2048, 2048, E); }
    SEAM(9);
    if (IN(10)) {
        { EpiScale E{(bf16_t*)(ws + WS_QK2), 2304, ss3, ssN}; run_gemm(lds, HBB, (const bf16_t*)(ws + WS_WQKV), T, 2304, 2048, E); }
        { EpiScale E{(bf16_t*)(ws + WS_VT2), T, ssN, ss3}; run_gemm(lds, (const bf16_t*)(ws + WS_WQKV) + (size_t)2304 * 2048, HBB, 256, T, 2048, E, 576); }
        { EpiScale E{(bf16_t*)(ws + WS_PP), 2048, ssN, ssN}; run_gemm(lds, (const bf16_t*)(ws + WS_PB) + (size_t)T * 256, (const bf16_t*)(ws + WS_WPR) + (size_t)D * 256, T, 2048, 256, E, 576 + 64); }
        if (gridDim.x == 256 && blockIdx.x >= 128)
        {   cvt_rows_fp8(p.in[18], ws + WS_VB, (float*)(ws + WS_VSC), 16384, 2 * 16384, ((int)blockIdx.x - 128) * 8 + (int)(threadIdx.x >> 6), 128 * 8, (int)(threadIdx.x & 63), 0);
            const int wave2 = (int)(threadIdx.x >> 6), lane2 = (int)(threadIdx.x & 63); LAS float* scr = (LAS float*)(lds + wave2 * 16640);
            for (int it = ((int)blockIdx.x - 128) * 8 + wave2; it < 3 * 32 * 32; it += 128 * 8) { int r = it;
                if (tr_job(r, p.in[12], 2048, 2048, 0, 2048, (bf16_t*)(ws + WS_WO), nullptr, 0, 1.f, scr, lane2)) continue;
                if (tr_job(r, p.in[14] + (size_t)D * D, 2048, 2048, 0, 2048, (bf16_t*)(ws + WS_WPQ) + (size_t)D * D, p.in[13] + D, 0, 1.f, scr, lane2)) continue;
                tr_job(r, p.in[20] + (size_t)D * D, 2048, 2048, 0, 2048, (bf16_t*)(ws + WS_WG) + (size_t)D * D, p.in[19] + D, 0, 1.f, scr, lane2); } }
    }
    SEAM(10);
    if (IN(11)) swa_phase(p, lds);
    SEAM(11);
    if (IN(12)) { EpiRes<false, false> E{HBB, HBA, SSP + (size_t)2 * T * 32, nullptr, ssN}; run_gemm(lds, (const bf16_t*)(ws + WS_O), (const bf16_t*)(ws + WS_WO), T, 2048, 2048, E); }
    SEAM(12);
    if (IN(13)) { EpiScale E{(bf16_t*)(ws + WS_QK), 2048, ss4, ssN}; run_gemm(lds, HBA, (const bf16_t*)(ws + WS_WPQ) + (size_t)D * D, T, 2048, 2048, E); }
    SEAM(13);
    if (IN(14)) { peer_topk(p, lds, 1, ss4); peer_xquant(p, 1, ss4, HBA); }
    SEAM(14);
    if (IN(15)) { peer_upass(p, 1); xcd_barrier(xbar); peer_combine(p, 1); xcd_barrier(xbar); peer_vpass(p, 1, SSQ + (size_t)T * 16, HBA, HBB); }
    SEAM(15);
    if (IN(16)) { EpiRes<true, false> E{HBB, HBA, SSP + (size_t)3 * T * 32, (const bf16_t*)(ws + WS_PP), ss5}; run_gemm(lds, HBB, (const bf16_t*)(ws + WS_WG) + (size_t)D * D, T, 2048, 2048, E); }
    SEAM(16);
    if (IN(17)) final_phase(p, HBA);
#undef IN
#undef SEAM
}

constexpr int N_PHASES = 18;
extern "C" void kernel_launch(void* const* d_in, const int* in_sizes, int n_in, void* d_out, int out_size, void* d_ws, size_t ws_size, hipStream_t stream) {
    static int grid = 0;
    if (grid == 0) {
        if (n_in != 23 || out_size != T * D || ws_size < WS_END) { fprintf(stderr, "kernel_launch: unexpected shapes (n_in %d out %d ws %zu need %zu)\n", n_in, out_size, ws_size, (size_t)WS_END); grid = -1; return; }
        int dev = 0, cus = 0, per_cu = 0;
        (void)hipGetDevice(&dev); (void)hipDeviceGetAttribute(&cus, hipDeviceAttributeMultiprocessorCount, dev);
        if (hipFuncSetAttribute((const void*)yoco_fwd, hipFuncAttributeMaxDynamicSharedMemorySize, LDS_BYTES) != hipSuccess) { fprintf(stderr, "kernel_launch: hipFuncSetAttribute failed\n"); grid = -1; return; }
        if (hipOccupancyMaxActiveBlocksPerMultiprocessor(&per_cu, (const void*)yoco_fwd, 512, LDS_BYTES) != hipSuccess || per_cu < 1) { fprintf(stderr, "kernel_launch: occupancy query says %d\n", per_cu); per_cu = 1; }
        (void)hipGetLastError();
        grid = cus * per_cu;
        fprintf(stderr, "kernel_launch: grid %d (cus %d x %d)\n", grid, cus, per_cu);
    }
    if (grid < 0) return;
    if (hipMemsetAsync((char*)d_ws + WS_BAR, 0, XCD_BAR_WORDS * 4, stream) != hipSuccess) { fprintf(stderr, "kernel_launch: hipMemsetAsync failed\n"); return; }
    Params p{};
    for (int i = 0; i < 23; ++i) p.in[i] = (const float*)d_in[i];
    p.out = (float*)d_out; p.ws = (unsigned char*)d_ws; p.ph_lo = 0; p.ph_hi = N_PHASES;
    void* args[] = {&p};
    hipError_t e = hipLaunchCooperativeKernel((const void*)yoco_fwd, dim3(grid), dim3(512), args, LDS_BYTES, stream);
    if (e != hipSuccess) fprintf(stderr, "kernel_launch: cooperative launch failed: %s (grid %d)\n", hipGetErrorString(e), grid);
}
```
